# Optimizing an MI355X kernel written in HIP

```python
import jax, jax.numpy as jnp
from jax import lax
import numpy as np

D_MODEL = 2048
BATCH = 32
SEQ = 256
DEPTH = 2
DEC_BATCH = 4
DEC_SEQ = 2048
PAST_LEN = 256

GRID_W = 64
HEAD_DIM = 128
ATTN_WIDTH = D_MODEL // 2
ATTN_HEADS = ATTN_WIDTH // HEAD_DIM
ATTN_KV_HEADS = 2
ATTN_GROUP = ATTN_HEADS // ATTN_KV_HEADS
KV_WIDTH = ATTN_KV_HEADS * HEAD_DIM
WINDOW = 128
BLOCK = 128
GLA_WIDTH = D_MODEL - ATTN_WIDTH
GLA_HEADS = 4
GLA_DV = GLA_WIDTH // GLA_HEADS
GLA_DK = GLA_DV // 2
GLA_KEY_WIDTH = GLA_HEADS * GLA_DK
GATE_RANK = 16
GATE_NORM = 16.0
GLA_CHUNK = 64
IN_SPLIT = (ATTN_WIDTH, KV_WIDTH, KV_WIDTH, GLA_KEY_WIDTH, GLA_KEY_WIDTH, GLA_WIDTH, GLA_WIDTH, GATE_RANK, GATE_RANK)
IN_WIDTH = ATTN_WIDTH + 2 * KV_WIDTH + 2 * GLA_KEY_WIDTH + 2 * GLA_WIDTH + 2 * GATE_RANK
D_FF = 5632
CONV_WIDTH = 3
ROPE_THETA = 10000.0
LN_EPS = 1e-5
NEG_INF = -1e30
DEEPNORM_ALPHA = (2 * DEPTH) ** 0.25
DEEPNORM_BETA = (8 * DEPTH) ** -0.25

kernel_name = 'hybrid_swa_gla_deepnorm_diffusion_step'


def _split_cols(a, sizes):
    offs, s = [], 0
    for n in sizes[:-1]:
        s += n
        offs.append(s)
    return jnp.split(a, offs, axis=-1)


def _layer_norm(x, w, b):
    xf = x.astype(jnp.float32)
    mu = jnp.mean(xf, axis=-1, keepdims=True)
    var = jnp.mean(jnp.square(xf - mu), axis=-1, keepdims=True)
    y = (xf - mu) * lax.rsqrt(var + LN_EPS) * w.astype(jnp.float32) + b.astype(jnp.float32)
    return y.astype(x.dtype)


def _rope_2d(x):
    T = x.shape[1]
    rows = T // GRID_W
    row = jnp.repeat(jnp.arange(rows), GRID_W).astype(jnp.float32)
    col = jnp.tile(jnp.arange(GRID_W), rows).astype(jnp.float32)
    half = HEAD_DIM // 2
    n_freq = half // 2
    freqs = ROPE_THETA ** (-jnp.arange(n_freq, dtype=jnp.float32) / n_freq)

    def rot(xa, pos):
        ang = pos[:, None] * freqs[None, :]
        cos = jnp.cos(ang)[None, :, None, :]
        sin = jnp.sin(ang)[None, :, None, :]
        x1, x2 = xa[..., :n_freq], xa[..., n_freq:]
        return jnp.concatenate([x1 * cos - x2 * sin, x1 * sin + x2 * cos], axis=-1)

    xf = x.astype(jnp.float32)
    return jnp.concatenate([rot(xf[..., :half], row), rot(xf[..., half:], col)], axis=-1).astype(x.dtype)


def _sink_softmax(sink, s):
    sk = sink.astype(jnp.float32).reshape(1, ATTN_KV_HEADS, ATTN_GROUP, 1, 1)
    sk = jnp.broadcast_to(sk, s.shape[:-1] + (1,))
    p = jax.nn.softmax(jnp.concatenate([sk, s], axis=-1), axis=-1)
    return p[..., 1:]


def _context_attention(q, k, v, sink):
    B, S = q.shape[:2]
    nb = S // BLOCK
    scale = HEAD_DIM ** -0.5
    qb = q.reshape(B, nb, BLOCK, ATTN_KV_HEADS, ATTN_GROUP, HEAD_DIM).transpose(1, 0, 2, 3, 4, 5)

    def one(qi):
        s = jnp.einsum('bqkgd,bskd->bkgqs', qi, k).astype(jnp.float32) * scale
        p = _sink_softmax(sink, s).astype(v.dtype)
        return jnp.einsum('bkgqs,bskd->bqkgd', p, v)

    o = lax.map(one, qb)
    return o.transpose(1, 0, 2, 3, 4, 5).reshape(B, S, ATTN_WIDTH)


def _latent_attention(q, k, v, ck, cv, sink):
    B, T = q.shape[:2]
    nb = T // BLOCK
    scale = HEAD_DIM ** -0.5
    qb = q.reshape(B, nb, BLOCK, ATTN_KV_HEADS, ATTN_GROUP, HEAD_DIM).transpose(1, 0, 2, 3, 4, 5)
    pad = ((0, 0), (BLOCK, BLOCK), (0, 0), (0, 0))
    kp = jnp.pad(k, pad)
    vp = jnp.pad(v, pad)
    key_off = jnp.arange(3 * BLOCK) - BLOCK
    q_off = jnp.arange(BLOCK)

    def one(args):
        qi, i = args
        start = i * BLOCK
        kb = lax.dynamic_slice_in_dim(kp, start, 3 * BLOCK, axis=1)
        vb = lax.dynamic_slice_in_dim(vp, start, 3 * BLOCK, axis=1)
        kpos = start + key_off
        qpos = start + q_off
        valid = (jnp.abs(qpos[:, None] - kpos[None, :]) <= WINDOW) & (kpos >= 0)[None, :] & (kpos < T)[None, :]
        s_loc = jnp.einsum('bqkgd,bskd->bkgqs', qi, kb).astype(jnp.float32) * scale
        s_loc = jnp.where(valid, s_loc, NEG_INF)
        s_ctx = jnp.einsum('bqkgd,bskd->bkgqs', qi, ck).astype(jnp.float32) * scale
        p = _sink_softmax(sink, jnp.concatenate([s_loc, s_ctx], axis=-1)).astype(v.dtype)
        return (jnp.einsum('bkgqs,bskd->bqkgd', p[..., :3 * BLOCK], vb)
                + jnp.einsum('bkgqs,bskd->bqkgd', p[..., 3 * BLOCK:], cv))

    o = lax.map(one, (qb, jnp.arange(nb)))
    return o.transpose(1, 0, 2, 3, 4, 5).reshape(B, T, ATTN_WIDTH)


def _gla_direction(q, k, v, g, s0):
    B, T, H, DK = q.shape
    DV = v.shape[-1]
    N = T // GLA_CHUNK
    q = q.reshape(B, N, GLA_CHUNK, H, DK)
    k = k.reshape(B, N, GLA_CHUNK, H, DK)
    v = v.reshape(B, N, GLA_CHUNK, H, DV)
    g = g.reshape(B, N, GLA_CHUNK, H, DK)
    b = jnp.cumsum(g, axis=2)
    b_last = b[:, :, -1:]
    qe = q * jnp.exp(b)
    ke = k * jnp.exp(-b)
    kd = k * jnp.exp(b_last - b)
    causal = jnp.tril(jnp.ones((GLA_CHUNK, GLA_CHUNK), dtype=bool))
    a = jnp.einsum('bnihd,bnjhd->bnhij', qe, ke)
    a = jnp.where(causal, a, 0.0)
    o = jnp.einsum('bnhij,bnjhv->bnihv', a, v)
    u = jnp.einsum('bnjhd,bnjhv->bnhdv', kd, v)
    decay = jnp.exp(b[:, :, -1])

    def step(s, inp):
        dcy, ui = inp
        return dcy[..., None] * s + ui, s

    s_fin, s_in = lax.scan(step, s0, (decay.transpose(1, 0, 2, 3), u.transpose(1, 0, 2, 3, 4)))
    s_in = s_in.transpose(1, 0, 2, 3, 4)
    o = o + jnp.einsum('bnihd,bnhdv->bnihv', qe, s_in)
    return o.reshape(B, T, H, DV), s_fin


def _gla(gq, gk, gv, gog, lr_f, lr_b, p, s0f, s0b):
    B, T = gq.shape[:2]
    f32 = jnp.float32
    q = gq.reshape(B, T, GLA_HEADS, GLA_DK).astype(f32) * (GLA_DK ** -0.5)
    k = gk.reshape(B, T, GLA_HEADS, GLA_DK).astype(f32)
    v = gv.reshape(B, T, GLA_HEADS, GLA_DV).astype(f32)
    gf = jax.nn.log_sigmoid((lr_f @ p['w_gate_f'] + p['b_gate_f']).astype(f32)) / GATE_NORM
    gb = jax.nn.log_sigmoid((lr_b @ p['w_gate_b'] + p['b_gate_b']).astype(f32)) / GATE_NORM
    gf = gf.reshape(B, T, GLA_HEADS, GLA_DK)
    gb = gb.reshape(B, T, GLA_HEADS, GLA_DK)
    of, sf = _gla_direction(q, k, v, gf, s0f.astype(f32))
    ob, sb = _gla_direction(q[:, ::-1], k[:, ::-1], v[:, ::-1], gb[:, ::-1], s0b.astype(f32))
    o = of + ob[:, ::-1]
    o = o * lax.rsqrt(jnp.mean(jnp.square(o), axis=-1, keepdims=True) + LN_EPS) * p['gla_norm_w'].astype(f32)
    o = o.reshape(B, T, GLA_WIDTH) * jax.nn.silu(gog.astype(f32))
    return o.astype(gq.dtype), sf.astype(gq.dtype), sb.astype(gq.dtype)


def _mixer(h, p, s0f, s0b, ctx_kv):
    B, T = h.shape[:2]
    q, k, v, gq, gk, gv, gog, lr_f, lr_b = _split_cols(h @ p['w_in'], IN_SPLIT)
    q = q.reshape(B, T, ATTN_HEADS, HEAD_DIM)
    k = k.reshape(B, T, ATTN_KV_HEADS, HEAD_DIM)
    v = v.reshape(B, T, ATTN_KV_HEADS, HEAD_DIM)
    if ctx_kv is None:
        o_att = _context_attention(q, k, v, p['attn_sink'])
    else:
        q = _rope_2d(q)
        k = _rope_2d(k)
        o_att = _latent_attention(q, k, v, ctx_kv[0], ctx_kv[1], p['attn_sink'])
    o_gla, sf, sb = _gla(gq, gk, gv, gog, lr_f, lr_b, p, s0f, s0b)
    out = jnp.concatenate([o_att, o_gla], axis=-1) @ p['w_out']
    return out, k, v, sf, sb


def _conv_ffn(h, p):
    u = h @ p['w_up']
    up = jnp.pad(u, ((0, 0), (1, 1), (0, 0)))
    w = p['conv_w']
    u = up[:, :-2] * w[0] + up[:, 1:-1] * w[1] + up[:, 2:] * w[2] + p['conv_b']
    a, g = jnp.split(u, 2, axis=-1)
    return (jax.nn.silu(g) * a) @ p['w_down']


def _layer(x, mods, p, s0f, s0b, ctx_kv):
    sh1, sc1, g1, sh2, sc2, g2 = jnp.split(mods, 6, axis=-1)
    out, k, v, sf, sb = _mixer(x * (1 + sc1) + sh1, p, s0f, s0b, ctx_kv)
    x = _layer_norm(DEEPNORM_ALPHA * x + g1 * out, p['ln1_w'], p['ln1_b'])
    f = _conv_ffn(x * (1 + sc2) + sh2, p)
    x = _layer_norm(DEEPNORM_ALPHA * x + g2 * f, p['ln2_w'], p['ln2_b'])
    return x, k, v, sf, sb


def setup_inputs(seed: int = 0) -> dict:
    key = jax.random.key(seed)
    ks = jax.random.split(key, 32)
    f32 = jnp.float32

    def nrm(k, shape, scale=1.0):
        return jax.random.normal(k, shape, f32) * scale

    return {
        'x_prompt': nrm(ks[0], (BATCH, SEQ, D_MODEL)),
        'x_sample': nrm(ks[1], (DEC_BATCH, DEC_SEQ, D_MODEL)),
        'cache_k': nrm(ks[2], (DEC_BATCH, DEPTH, PAST_LEN, ATTN_KV_HEADS, HEAD_DIM)),
        'cache_v': nrm(ks[3], (DEC_BATCH, DEPTH, PAST_LEN, ATTN_KV_HEADS, HEAD_DIM)),
        'state_gla_fwd': nrm(ks[4], (DEC_BATCH, DEPTH, GLA_HEADS, GLA_DK, GLA_DV)),
        'state_gla_bwd': nrm(ks[5], (DEC_BATCH, DEPTH, GLA_HEADS, GLA_DK, GLA_DV)),
        'c': nrm(ks[6], (DEC_BATCH, D_MODEL)),
        'c_ctx': nrm(ks[7], (D_MODEL,)),
        'w_ada': nrm(ks[8], (DEPTH, D_MODEL, 6 * D_MODEL), D_MODEL ** -0.5),
        'b_ada': nrm(ks[9], (DEPTH, 6 * D_MODEL), 0.02),
        'w_in': nrm(ks[10], (DEPTH, D_MODEL, IN_WIDTH), D_MODEL ** -0.5),
        'attn_sink': nrm(ks[11], (DEPTH, ATTN_HEADS), 0.5),
        'w_gate_f': nrm(ks[12], (DEPTH, GATE_RANK, GLA_KEY_WIDTH), GATE_RANK ** -0.5),
        'b_gate_f': nrm(ks[13], (DEPTH, GLA_KEY_WIDTH), 0.1),
        'w_gate_b': nrm(ks[14], (DEPTH, GATE_RANK, GLA_KEY_WIDTH), GATE_RANK ** -0.5),
        'b_gate_b': nrm(ks[15], (DEPTH, GLA_KEY_WIDTH), 0.1),
        'gla_norm_w': 1.0 + nrm(ks[16], (DEPTH, GLA_DV), 0.02),
        'w_out': nrm(ks[17], (DEPTH, D_MODEL, D_MODEL), D_MODEL ** -0.5 * DEEPNORM_BETA),
        'ln1_w': 1.0 + nrm(ks[18], (DEPTH, D_MODEL), 0.02),
        'ln1_b': nrm(ks[19], (DEPTH, D_MODEL), 0.02),
        'w_up': nrm(ks[20], (DEPTH, D_MODEL, 2 * D_FF), D_MODEL ** -0.5),
        'conv_w': nrm(ks[21], (DEPTH, CONV_WIDTH, 2 * D_FF), CONV_WIDTH ** -0.5),
        'conv_b': nrm(ks[22], (DEPTH, 2 * D_FF), 0.02),
        'w_down': nrm(ks[23], (DEPTH, D_FF, D_MODEL), D_FF ** -0.5 * DEEPNORM_BETA),
        'ln2_w': 1.0 + nrm(ks[24], (DEPTH, D_MODEL), 0.02),
        'ln2_b': nrm(ks[25], (DEPTH, D_MODEL), 0.02),
    }


def reference(x_prompt, x_sample, cache_k, cache_v, state_gla_fwd, state_gla_bwd, c, c_ctx,
              w_ada, b_ada, w_in, attn_sink, w_gate_f, b_gate_f, w_gate_b, b_gate_b, gla_norm_w,
              w_out, ln1_w, ln1_b, w_up, conv_w, conv_b, w_down, ln2_w, ln2_b):
    xp, xs = x_prompt, x_sample
    new_k, new_v, new_sf, new_sb = [], [], [], []
    for l in range(DEPTH):
        p = {'w_in': w_in[l], 'attn_sink': attn_sink[l], 'w_gate_f': w_gate_f[l], 'b_gate_f': b_gate_f[l],
             'w_gate_b': w_gate_b[l], 'b_gate_b': b_gate_b[l], 'gla_norm_w': gla_norm_w[l], 'w_out': w_out[l],
             'ln1_w': ln1_w[l], 'ln1_b': ln1_b[l], 'w_up': w_up[l], 'conv_w': conv_w[l], 'conv_b': conv_b[l],
             'w_down': w_down[l], 'ln2_w': ln2_w[l], 'ln2_b': ln2_b[l]}
        mods_ctx = (jax.nn.silu(c_ctx) @ w_ada[l] + b_ada[l])[None, None, :]
        s_zero = jnp.zeros((xp.shape[0], GLA_HEADS, GLA_DK, GLA_DV), jnp.float32)
        xp, k_l, v_l, sf_l, sb_l = _layer(xp, mods_ctx, p, s_zero, s_zero, None)
        new_k.append(k_l)
        new_v.append(v_l)
        new_sf.append(sf_l)
        new_sb.append(sb_l)
        mods_lat = (jax.nn.silu(c) @ w_ada[l] + b_ada[l])[:, None, :]
        xs = _layer(xs, mods_lat, p, state_gla_fwd[:, l], state_gla_bwd[:, l], (cache_k[:, l], cache_v[:, l]))[0]
    return (xp, xs, jnp.stack(new_k, axis=1), jnp.stack(new_v, axis=1), jnp.stack(new_sf, axis=1), jnp.stack(new_sb, axis=1))
```

```cpp
#include <hip/hip_runtime.h>
#include <hip/hip_cooperative_groups.h>
#include <cstdio>
#include <cstdint>
namespace cg = cooperative_groups;
namespace pg8 {
#define PG8_LAS __attribute__((address_space(3)))
typedef unsigned short bf16_t;
typedef short bf16x8 __attribute__((ext_vector_type(8)));
typedef float f32x4 __attribute__((ext_vector_type(4)));
typedef unsigned u32x4 __attribute__((ext_vector_type(4)));
constexpr int BM = 256, BK = 64, HALF = 128, HTB = HALF * BK * 2  , STAGE_BYTES = 8 * HTB, NXCD = 8, WGM = 8;

__host__ __device__ __forceinline__ int lds_byte(int r, int c) { const int st = (r >> 4) * 2 + (c >> 5), rr = r & 15, cc = c & 31, ob = rr * 64 + cc * 2; return st * 1024 + (ob ^ (((ob >> 9) & 1) << 5)); }
__host__ __device__ __forceinline__ void stage_rc(int b, int& R, int& C) { const int st = b / 1024, sb = b % 1024, swz = sb ^ (((sb >> 9) & 1) << 5); R = (st >> 1) * 16 + swz / 64; C = (st & 1) * 32 + (swz % 64) / 2; }
__host__ __device__ __forceinline__ int perm32(int rho) { const int n = rho >> 4, i = rho & 15; return 8 * (i >> 2) + 4 * n + (i & 3); }

struct Unit { int pm, pn; };
struct Gemm { const bf16_t* A; const bf16_t* Bt; int M, N, K; };

struct StaticOrder {
    int nM, nN, nwg, G, c;
    __host__ __device__ void init(int M, int N, int G_, int c_) { nM = M / BM; nN = N / BM; nwg = nM * nN; G = G_; c = c_; }
    __host__ __device__ bool next(int i, Unit& u) const {
        const long L = (long)i * G + c; if (L >= nwg) return false;
        int wgid = (int)L; { const int q = nwg / NXCD, r = nwg % NXCD, xcd = wgid % NXCD, off = wgid / NXCD; wgid = (xcd < r ? xcd * (q + 1) : r * (q + 1) + (xcd - r) * q) + off; }
        const int nig = WGM * nN, gid = wgid / nig, fm = gid * WGM, gsz = (nM - fm) < WGM ? (nM - fm) : WGM;
        u.pm = fm + ((wgid % nig) % gsz); u.pn = (wgid % nig) / gsz; return true;
    }
    __device__ __forceinline__ void a_ready(const Unit&) const {}
    __device__ __forceinline__ void done(const Unit&) const {}
};

template <class Epi, class Sched, bool ALIGN_EPI = false, bool SP2 = false>
__device__ __forceinline__ void gemm_phase(PG8_LAS unsigned char* lds, const Gemm g, const Sched& S, const Epi& E, const int wid, const int tid) {
    const int lane = tid & 63, wr = wid >> 2, wc = wid & 3, fr = lane & 15, fq = lane >> 4;
    const int K = g.K, nt = K / BK;
    unsigned voffA[2], voffB[2];
#pragma unroll
    for (int i = 0; i < 2; ++i) { int R, C; stage_rc(tid * 16 + i * 8192, R, C); const int Rb = Epi::PERM ? ((R & ~31) + perm32(R & 31)) : R;
        voffA[i] = (unsigned)(R * K + C) * 2u; voffB[i] = (unsigned)(Rb * K + C) * 2u; }
    const size_t kstep = (size_t)(BK * 2);
    const size_t hstep = (size_t)HALF * K * 2;
    const size_t tstep = 2 * hstep;
    const unsigned ldsw = (unsigned)wid * 1024u;
    const int aoff = lds_byte(wr * 64 + fr, fq * 8), boff = lds_byte(wc * 32 + fr, fq * 8);
#define PG8_SA(b, h) (((b) * 2 + (h)) * HTB)
#define PG8_SB(b, h) ((4 + (b) * 2 + (h)) * HTB)
#define PG8_STAGE(bufoff, gbase, voff) do { _Pragma("unroll") for (int _i = 0; _i < 2; ++_i) \
        __builtin_amdgcn_global_load_lds((const unsigned*)((const char*)(gbase) + (voff)[_i]), (PG8_LAS unsigned*)(lds + (bufoff) + ldsw + _i * 8192), 16, 0, 0); } while (0)
#define PG8_LDA(dst, b, h) do { _Pragma("unroll") for (int m = 0; m < 4; ++m) _Pragma("unroll") for (int k = 0; k < 2; ++k) dst[m][k] = *(const PG8_LAS bf16x8*)(lds + PG8_SA(b, h) + aoff + m * 2048 + k * 1024); } while (0)
#define PG8_LDB(dst, b, h) do { _Pragma("unroll") for (int n = 0; n < 2; ++n) _Pragma("unroll") for (int k = 0; k < 2; ++k) dst[n][k] = *(const PG8_LAS bf16x8*)(lds + PG8_SB(b, h) + boff + n * 2048 + k * 1024); } while (0)
#define PG8_MMA(ai, bj, At, Bt) do { __builtin_amdgcn_s_setprio(1); _Pragma("unroll") for (int m = 0; m < 4; ++m) _Pragma("unroll") for (int n = 0; n < 2; ++n) _Pragma("unroll") for (int k = 0; k < 2; ++k) \
        acc[ai][bj][m][n] = __builtin_amdgcn_mfma_f32_16x16x32_bf16(Bt[n][k], At[m][k], acc[ai][bj][m][n], 0, 0, 0); __builtin_amdgcn_s_setprio(0); } while (0)
#define PG8_WAIT_V(n) asm volatile("s_waitcnt vmcnt(" #n ")" ::: "memory")
#define PG8_WAIT_L(n) asm volatile("s_waitcnt lgkmcnt(" #n ")" ::: "memory")
#define PG8_BAR __builtin_amdgcn_s_barrier()
#define PG8_SCHED __builtin_amdgcn_sched_barrier(0)
    Unit cur, nxt; int ui = 0;
    if (!S.next(0, cur)) return;
    f32x4 acc[2][2][4][2];
#pragma unroll
    for (int a = 0; a < 2; ++a)
#pragma unroll
        for (int b = 0; b < 2; ++b)
#pragma unroll
            for (int m = 0; m < 4; ++m)
#pragma unroll
                for (int n = 0; n < 2; ++n) acc[a][b][m][n] = (f32x4){0.f, 0.f, 0.f, 0.f};
    bf16x8 At[4][2], B0[2][2], B1[2][2];
    const char* cA = (const char*)g.A + (size_t)cur.pm * tstep; const char* cB = (const char*)g.Bt + (size_t)cur.pn * tstep;
    S.a_ready(cur);
    if constexpr (SP2) {
        PG8_STAGE(PG8_SB(0, 0), cB, voffB); PG8_STAGE(PG8_SB(0, 1), cB + hstep, voffB); PG8_STAGE(PG8_SA(0, 0), cA, voffA); PG8_STAGE(PG8_SA(0, 1), cA + hstep, voffA);
        if (wr == 1) PG8_BAR;
        PG8_WAIT_V(2); PG8_BAR;
        PG8_STAGE(PG8_SB(1, 0), cB + kstep, voffB); PG8_STAGE(PG8_SA(1, 0), cA + kstep, voffA); PG8_STAGE(PG8_SB(1, 1), cB + hstep + kstep, voffB);
        PG8_WAIT_V(6); PG8_BAR;
    } else {
        PG8_STAGE(PG8_SB(0, 0), cB, voffB); PG8_STAGE(PG8_SA(0, 0), cA, voffA); PG8_STAGE(PG8_SB(0, 1), cB + hstep, voffB); PG8_STAGE(PG8_SA(0, 1), cA + hstep, voffA);
        if (wr == 1) PG8_BAR;
        PG8_WAIT_V(4); PG8_BAR;
        PG8_STAGE(PG8_SB(1, 0), cB + kstep, voffB); PG8_STAGE(PG8_SA(1, 0), cA + kstep, voffA); PG8_STAGE(PG8_SB(1, 1), cB + hstep + kstep, voffB);
        PG8_WAIT_V(6); PG8_BAR;
    }
    for (;;) {
        const bool has_next = S.next(ui + 1, nxt);
        const char* nA = has_next ? (const char*)g.A + (size_t)nxt.pm * tstep : cA; const char* nB = has_next ? (const char*)g.Bt + (size_t)nxt.pn * tstep : cB;
        for (int t = 0; t < nt; t += 2) {
            const bool last = (t == nt - 2);
            const char* a1 = cA + (size_t)(t + 1) * kstep;
            const char* a2 = last ? nA : cA + (size_t)(t + 2) * kstep; const char* b2 = last ? nB : cB + (size_t)(t + 2) * kstep;
            const char* a3 = a2 + kstep; const char* b3 = b2 + kstep;
            if (last && has_next) S.a_ready(nxt);
            if constexpr (SP2) {
            PG8_LDB(B0, 0, 0); PG8_LDB(B1, 0, 1); PG8_SCHED; PG8_LDA(At, 0, 0); PG8_STAGE(PG8_SA(1, 1), a1 + hstep, voffA);
            PG8_WAIT_V(8); PG8_WAIT_L(0); PG8_BAR; PG8_MMA(0, 0, At, B0); PG8_MMA(0, 1, At, B1); PG8_BAR; PG8_SCHED;
            PG8_LDA(At, 0, 1); PG8_STAGE(PG8_SB(0, 0), b2, voffB); PG8_STAGE(PG8_SB(0, 1), b2 + hstep, voffB); PG8_STAGE(PG8_SA(0, 0), a2, voffA);
            PG8_WAIT_V(8); PG8_WAIT_L(0); PG8_BAR; PG8_MMA(1, 0, At, B0); PG8_MMA(1, 1, At, B1); PG8_BAR; PG8_SCHED;
            PG8_LDB(B0, 1, 0); PG8_LDB(B1, 1, 1); PG8_SCHED; PG8_LDA(At, 1, 0); PG8_STAGE(PG8_SA(0, 1), a2 + hstep, voffA);
            PG8_WAIT_V(8); PG8_WAIT_L(0); PG8_BAR; PG8_MMA(0, 0, At, B0); PG8_MMA(0, 1, At, B1); PG8_BAR; PG8_SCHED;
            PG8_LDA(At, 1, 1); PG8_STAGE(PG8_SB(1, 0), b3, voffB); PG8_STAGE(PG8_SB(1, 1), b3 + hstep, voffB); PG8_STAGE(PG8_SA(1, 0), a3, voffA);
            PG8_WAIT_V(8); PG8_WAIT_L(0); PG8_BAR; PG8_MMA(1, 0, At, B0); PG8_MMA(1, 1, At, B1); PG8_BAR; PG8_SCHED;
            } else {
            PG8_LDB(B0, 0, 0); PG8_SCHED; PG8_LDA(At, 0, 0); PG8_STAGE(PG8_SA(1, 1), a1 + hstep, voffA);
            PG8_WAIT_L(8); PG8_BAR; PG8_WAIT_L(0); PG8_MMA(0, 0, At, B0); PG8_BAR; PG8_SCHED;
            PG8_LDB(B1, 0, 1); PG8_STAGE(PG8_SB(0, 0), b2, voffB);
            PG8_BAR; PG8_WAIT_L(0); PG8_MMA(0, 1, At, B1); PG8_BAR;
            PG8_LDA(At, 0, 1); PG8_STAGE(PG8_SA(0, 0), a2, voffA);
            PG8_BAR; PG8_WAIT_L(0); PG8_MMA(1, 0, At, B0); PG8_BAR; PG8_SCHED;
            PG8_STAGE(PG8_SB(0, 1), b2 + hstep, voffB);
            PG8_WAIT_V(6); PG8_BAR; PG8_MMA(1, 1, At, B1); PG8_BAR;
            PG8_LDB(B0, 1, 0); PG8_SCHED; PG8_LDA(At, 1, 0); PG8_STAGE(PG8_SA(0, 1), a2 + hstep, voffA);
            PG8_WAIT_L(8); PG8_BAR; PG8_WAIT_L(0); PG8_MMA(0, 0, At, B0); PG8_BAR; PG8_SCHED;
            PG8_LDB(B1, 1, 1); PG8_STAGE(PG8_SB(1, 0), b3, voffB);
            PG8_BAR; PG8_WAIT_L(0); PG8_MMA(0, 1, At, B1); PG8_BAR;
            PG8_LDA(At, 1, 1); PG8_STAGE(PG8_SA(1, 0), a3, voffA);
            PG8_BAR; PG8_WAIT_L(0); PG8_MMA(1, 0, At, B0); PG8_BAR; PG8_SCHED;
            PG8_STAGE(PG8_SB(1, 1), b3 + hstep, voffB);
            PG8_WAIT_V(6); PG8_BAR; PG8_MMA(1, 1, At, B1); PG8_BAR;
            }
        }
        if constexpr (ALIGN_EPI) { if (wr == 0) PG8_BAR; }
        if constexpr (!Epi::AFTER_DRAIN) { E(acc, cur, wr, wc, fr, fq); S.done(cur); }
        if (!has_next) break;
#pragma unroll
        for (int a = 0; a < 2; ++a)
#pragma unroll
            for (int b = 0; b < 2; ++b)
#pragma unroll
                for (int m = 0; m < 4; ++m)
#pragma unroll
                    for (int n = 0; n < 2; ++n) acc[a][b][m][n] = (f32x4){0.f, 0.f, 0.f, 0.f};
        cur = nxt; cA = nA; cB = nB; ++ui;
        if constexpr (ALIGN_EPI) { if (wr == 1) PG8_BAR; }
    }
    PG8_WAIT_V(0);
    if constexpr (!ALIGN_EPI) { if (wr == 0) PG8_BAR; }
    PG8_BAR;
    if constexpr (Epi::AFTER_DRAIN) { E.fused(acc, cur, wr, wc, fr, fq, lds, wid, lane); S.done(cur); }
#undef PG8_SA
#undef PG8_SB
#undef PG8_STAGE
#undef PG8_LDA
#undef PG8_LDB
#undef PG8_MMA
#undef PG8_WAIT_V
#undef PG8_WAIT_L
#undef PG8_BAR
#undef PG8_SCHED
}
}

#ifndef MK_MULTI
#define MK_MULTI 0
#endif
#define LAS __attribute__((address_space(3)))
#define DI __device__ __forceinline__
typedef unsigned short bf16;
typedef float f32x4 __attribute__((ext_vector_type(4)));
typedef float f32x16 __attribute__((ext_vector_type(16)));
typedef short bf16x8 __attribute__((ext_vector_type(8)));
typedef short s16x4 __attribute__((ext_vector_type(4)));
typedef unsigned u32x4 __attribute__((ext_vector_type(4)));
typedef unsigned u32x2 __attribute__((ext_vector_type(2)));
typedef float f32x2_t __attribute__((ext_vector_type(2)));
typedef __bf16 bf16x2_t __attribute__((ext_vector_type(2)));

constexpr int MTOK = 16384, DM = 2048, NIN = 4640, NINP = 4864, DFF = 5632, NUP = 11264, NMODS = 12288, CTXR = 8192, PJP = 3328;
constexpr float LN_EPS = 1e-5f, DN_ALPHA = 1.4142135623730951f, LOG2E = 1.4426950408889634f;
constexpr size_t MiB = 1u << 20;
constexpr size_t WS_CTL = 0, WS_MODS = 1 * MiB, WS_ROPE = 2 * MiB, WS_CK = 3 * MiB, WS_CVT = 4 * MiB, WS_WIN = 5 * MiB;
constexpr size_t WS_WOUT = WS_WIN + 38 * MiB, WS_WUP = WS_WOUT + 16 * MiB, WS_WDN = WS_WUP + 88 * MiB, WS_H = WS_WDN + 44 * MiB;
constexpr size_t WS_XY = WS_H + 64 * MiB, WS_REG = WS_XY + 128 * MiB;
constexpr size_t WS_PROJ = WS_REG, WS_LR = WS_PROJ + 104 * MiB, WS_VT = WS_LR + 2 * MiB, WS_GVT = WS_VT + 8 * MiB, WS_OFB = WS_GVT + 32 * MiB, WS_OINT = WS_OFB + 64 * MiB, WS_CAT = WS_OINT + 64 * MiB;
constexpr size_t WS_GDEC = WS_CAT + 64 * MiB, WS_KR = WS_GDEC + 1 * MiB, WS_GQE = WS_H, WS_GKD = WS_H + 32 * MiB;
constexpr size_t WS_ERAW = WS_REG, WS_EPART = WS_REG + 8 * MiB, WS_ACT = WS_REG + 176 * MiB, WS_END = WS_REG + 352 * MiB;
static_assert(WS_KR + 4 * MiB <= WS_END, "ws map");
constexpr size_t WS_STATS = WS_MODS + 512 * 1024;
constexpr size_t OUT_K = 33554432, OUT_V = OUT_K + 4194304, OUT_SF = OUT_V + 4194304, OUT_SB = OUT_SF + 8388608;
constexpr int LDS_BYTES = 147456;
constexpr int NSUB = 10, NPHASE = 2 + 2 * NSUB;

struct Params {
    const float *xp, *xs, *cache_k, *cache_v, *st_f, *st_b, *c, *c_ctx, *w_ada, *b_ada, *w_in, *sink, *wgf, *bgf, *wgb, *bgb, *gnw, *w_out,
        *ln1w, *ln1b, *w_up, *conv_w, *conv_b, *w_down, *ln2w, *ln2b;
    float* out; unsigned char* ws; int ph_lo, ph_hi;
};

DI unsigned f2bf(float f) { unsigned u = __float_as_uint(f); return (u + 0x7fffu + ((u >> 16) & 1u)) >> 16; }
DI float bf2f(unsigned b) { return __uint_as_float(b << 16); }
DI unsigned pk2(float lo, float hi) { f32x2_t v = {lo, hi}; bf16x2_t b = __builtin_convertvector(v, bf16x2_t); return __builtin_bit_cast(unsigned, b); }
DI float fexp(float x) { return __builtin_amdgcn_exp2f(x * LOG2E); }
DI float flog(float x) { return __builtin_amdgcn_logf(x) * 0.6931471805599453f; }
DI float silu(float x) { return x * __builtin_amdgcn_rcpf(1.f + fexp(-x)); }
DI float wave_sum(float v) {
#pragma unroll
    for (int o = 1; o < 64; o <<= 1) v += __shfl_xor(v, o);
    return v;
}
DI int crow(int reg, int hh) { return (reg & 3) + 8 * (reg >> 2) + 4 * hh; }
DI f32x16 mfma32(bf16x8 a, bf16x8 b, f32x16 c) { return __builtin_amdgcn_mfma_f32_32x32x16_bf16(a, b, c, 0, 0, 0); }
DI bf16x8 pack8(const f32x16& x, int s) {
    u32x4 p; p.x = pk2(x[8 * s], x[8 * s + 1]); p.y = pk2(x[8 * s + 2], x[8 * s + 3]); p.z = pk2(x[8 * s + 4], x[8 * s + 5]); p.w = pk2(x[8 * s + 6], x[8 * s + 7]);
    return __builtin_bit_cast(bf16x8, p);
}
DI bf16x8 lds16(const LAS unsigned char* p) { return *(const LAS bf16x8*)p; }
DI bf16x8 lds8x2(const LAS unsigned char* p0, const LAS unsigned char* p1) {
    const s16x4 a = *(const LAS s16x4*)p0, b = *(const LAS s16x4*)p1; return __builtin_shufflevector(a, b, 0, 1, 2, 3, 4, 5, 6, 7);
}
DI const float* mods_ptr(const Params& P, int l, int mv) { return (const float*)(P.ws + WS_MODS) + (size_t)(l * 5 + mv) * NMODS; }
DI int mv_of_row(int row) { return row < CTXR ? 0 : 1 + ((row - CTXR) >> 11); }

struct EpiIn {
    static constexpr bool PERM = true, AFTER_DRAIN = false;
    bf16* proj; float* lr; bf16* vt; bf16* gvt; float* outk; float* outv;
    DI void operator()(const pg8::f32x4 (&acc)[2][2][4][2], const pg8::Unit& u, int wr, int wc, int fr, int fq) const {
        const int pn = u.pn, row0 = u.pm * 256 + wr * 64 + fr, colt = pn * 256 + wc * 32 + fq * 8;
        if (pn == 18) {
            if (wc == 0) {
#pragma unroll
                for (int ai = 0; ai < 2; ++ai)
#pragma unroll
                    for (int m = 0; m < 4; ++m)
#pragma unroll
                        for (int n = 0; n < 2; ++n) *(f32x4*)(lr + (size_t)(row0 + ai * 128 + m * 16) * 32 + fq * 8 + n * 4) = acc[ai][0][m][n];
            }
        } else if (pn == 5 || (pn >= 10 && pn <= 13)) {
            bf16* T = (pn == 5) ? vt : gvt; const int cb = colt - ((pn == 5) ? 1280 : 2560);
#pragma unroll
            for (int ai = 0; ai < 2; ++ai)
#pragma unroll
                for (int bj = 0; bj < 2; ++bj)
#pragma unroll
                    for (int m = 0; m < 4; ++m)
#pragma unroll
                        for (int n = 0; n < 2; ++n) {
                            const int row = row0 + ai * 128 + m * 16, c = cb + bj * 128 + n * 4; const f32x4 v = acc[ai][bj][m][n];
#pragma unroll
                            for (int j = 0; j < 4; ++j) T[(size_t)(c + j) * MTOK + row] = (bf16)f2bf(v[j]);
                            if (pn == 5 && u.pm < 32) *(f32x4*)(outv + (size_t)(row >> 8) * 131072 + (row & 255) * 256 + c) = v;
                        }
        } else {
#pragma unroll
            for (int ai = 0; ai < 2; ++ai)
#pragma unroll
                for (int bj = 0; bj < 2; ++bj)
#pragma unroll
                    for (int m = 0; m < 4; ++m) {
                        const int row = row0 + ai * 128 + m * 16, col = colt + bj * 128; const f32x4 v0 = acc[ai][bj][m][0], v1 = acc[ai][bj][m][1];
                        u32x4 w; w.x = pk2(v0[0], v0[1]); w.y = pk2(v0[2], v0[3]); w.z = pk2(v1[0], v1[1]); w.w = pk2(v1[2], v1[3]);
                        *(u32x4*)(proj + (size_t)row * PJP + (col < 1280 ? col : col < 2560 ? col - 256 : col - 1280)) = w;
                        if (pn == 4 && u.pm < 32) { float* ok = outk + (size_t)(row >> 8) * 131072 + (row & 255) * 256 + (col - 1024); *(f32x4*)ok = v0; *(f32x4*)(ok + 4) = v1; }
                    }
        }
    }
};
struct EpiRes {
    static constexpr bool PERM = true, AFTER_DRAIN = false;
    const float* xa; const float* xb; const bf16* yin; bf16* y; const float* gate; const float2* stats; const float* lnw; const float* lnb;
    DI void operator()(const pg8::f32x4 (&acc)[2][2][4][2], const pg8::Unit& u, int wr, int wc, int fr, int fq) const {
        asm volatile("" : "+v"(fr), "+v"(fq));
        const int row0 = u.pm * 256 + wr * 64 + fr, colp = u.pn * 256 + wc * 32 + fq * 8;
        const int mv = u.pm < 32 ? 0 : 1 + ((u.pm - 32) >> 3);
        const float* g = gate + (size_t)mv * NMODS;
        const float* xbase = u.pm < 32 ? xa : xb - (size_t)CTXR * DM;
        float2 st[2][4];
#pragma unroll
        for (int ai = 0; ai < 2; ++ai)
#pragma unroll
            for (int m = 0; m < 4; ++m) st[ai][m] = yin ? stats[row0 + ai * 128 + m * 16] : make_float2(0.f, 1.f);
#pragma unroll
        for (int bj = 0; bj < 2; ++bj) {
            const int col = colp + bj * 128;
            const f32x4 gv0 = *(const f32x4*)(g + col), gv1 = *(const f32x4*)(g + col + 4);
            f32x4 lw0 = {1.f, 1.f, 1.f, 1.f}, lw1 = lw0, lb0 = {0.f, 0.f, 0.f, 0.f}, lb1 = lb0;
            if (yin) { lw0 = *(const f32x4*)(lnw + col); lw1 = *(const f32x4*)(lnw + col + 4); lb0 = *(const f32x4*)(lnb + col); lb1 = *(const f32x4*)(lnb + col + 4); }
#pragma unroll
            for (int ai = 0; ai < 2; ++ai)
#pragma unroll
                for (int m = 0; m < 4; ++m) {
                    const size_t o = (size_t)(row0 + ai * 128 + m * 16) * DM + col;
                    f32x4 x0, x1;
                    if (yin) { const u32x4 t = *(const u32x4*)(yin + o);
                        x0.x = bf2f(t.x & 0xffffu); x0.y = bf2f(t.x >> 16); x0.z = bf2f(t.y & 0xffffu); x0.w = bf2f(t.y >> 16);
                        x1.x = bf2f(t.z & 0xffffu); x1.y = bf2f(t.z >> 16); x1.z = bf2f(t.w & 0xffffu); x1.w = bf2f(t.w >> 16);
                        x0 = (x0 - st[ai][m].x) * st[ai][m].y * lw0 + lb0; x1 = (x1 - st[ai][m].x) * st[ai][m].y * lw1 + lb1; }
                    else { x0 = *(const f32x4*)(xbase + o); x1 = *(const f32x4*)(xbase + o + 4); }
                    const f32x4 r0 = x0 * DN_ALPHA + gv0 * acc[ai][bj][m][0], r1 = x1 * DN_ALPHA + gv1 * acc[ai][bj][m][1];
                    u32x4 w; w.x = pk2(r0.x, r0.y); w.y = pk2(r0.z, r0.w); w.z = pk2(r1.x, r1.y); w.w = pk2(r1.z, r1.w);
                    *(u32x4*)(y + o) = w;
                }
        }
    }
};
template <int CTRL> DI float dppm(float old, float v) { return __builtin_bit_cast(float, __builtin_amdgcn_update_dpp(__builtin_bit_cast(int, old), __builtin_bit_cast(int, v), CTRL, 0xf, 0xf, false)); }
struct EpiUpConv {
    static constexpr bool PERM = true, AFTER_DRAIN = false;
    bf16* ACT; float* eraw; float* epart; const float* cw; const float* cb; LAS float* xl;
    DI void operator()(const pg8::f32x4 (&acc)[2][2][4][2], const pg8::Unit& u, int wr, int wc, int fr, int fq) const {
        asm volatile("" : "+v"(fr), "+v"(fq));
#pragma unroll
        for (int ai = 0; ai < 2; ++ai)
#pragma unroll
            for (int bj = 0; bj < 2; ++bj)
#pragma unroll
                for (int n = 0; n < 2; ++n) {
                    const int col = wc * 32 + fq * 8 + n * 4, s = 2 * ai + wr;
                    if (fr == 0) *(LAS f32x4*)(xl + ((s * 2 + 0) * 2 + bj) * 128 + col) = acc[ai][bj][0][n];
                    if (fr == 15) *(LAS f32x4*)(xl + ((s * 2 + 1) * 2 + bj) * 128 + col) = acc[ai][bj][3][n];
                }
        asm volatile("s_waitcnt lgkmcnt(0)" ::: "memory"); __builtin_amdgcn_s_barrier(); asm volatile("" ::: "memory");
#pragma unroll
        for (int n = 0; n < 2; ++n) {
            const int colw = wc * 32 + fq * 8 + n * 4, ffc = u.pn * 128 + colw;
            f32x4 w0[2], w1[2], w2[2], bb[2];
#pragma unroll
            for (int bj = 0; bj < 2; ++bj) { const int c = ffc + bj * DFF; w0[bj] = *(const f32x4*)(cw + c); w1[bj] = *(const f32x4*)(cw + NUP + c); w2[bj] = *(const f32x4*)(cw + 2 * NUP + c); bb[bj] = *(const f32x4*)(cb + c); }
#pragma unroll
            for (int ai = 0; ai < 2; ++ai) {
                const int s = 2 * ai + wr;
                f32x4 top[2], bot[2];
#pragma unroll
                for (int bj = 0; bj < 2; ++bj) {
                    top[bj] = (f32x4){0.f, 0.f, 0.f, 0.f}; bot[bj] = top[bj];
                    if (s > 0) top[bj] = *(const LAS f32x4*)(xl + (((s - 1) * 2 + 1) * 2 + bj) * 128 + colw);
                    if (s < 3) bot[bj] = *(const LAS f32x4*)(xl + (((s + 1) * 2 + 0) * 2 + bj) * 128 + colw);
                }
#pragma unroll
                for (int m = 0; m < 4; ++m) {
                    f32x4 pre[2];
#pragma unroll
                    for (int bj = 0; bj < 2; ++bj)
#pragma unroll
                        for (int j = 0; j < 4; ++j) {
                            const float v = acc[ai][bj][m][n][j];
                            const float oldu = m > 0 ? dppm<0x121>(0.f, acc[ai][bj][m > 0 ? m - 1 : 0][n][j]) : top[bj][j];
                            const float oldd = m < 3 ? dppm<0x12F>(0.f, acc[ai][bj][m < 3 ? m + 1 : 3][n][j]) : bot[bj][j];
                            const float up = dppm<0x111>(oldu, v), dn = dppm<0x101>(oldd, v);
                            pre[bj][j] = w0[bj][j] * up + w1[bj][j] * v + w2[bj][j] * dn + bb[bj][j];
                        }
                    const int row = u.pm * 256 + ai * 128 + wr * 64 + m * 16 + fr;
                    const f32x4 a = pre[0], g = pre[1];
                    u32x2 w; w.x = pk2(silu(g[0]) * a[0], silu(g[1]) * a[1]); w.y = pk2(silu(g[2]) * a[2], silu(g[3]) * a[3]);
                    *(u32x2*)(ACT + (size_t)row * DFF + ffc) = w;
                    const bool etop = (ai == 0 && m == 0 && wr == 0 && fr == 0), ebot = (ai == 1 && m == 3 && wr == 1 && fr == 15);
                    if (etop || ebot) {
                        const size_t eo = (size_t)(u.pm * 2 + (ebot ? 1 : 0)) * NUP + ffc;
                        *(f32x4*)(eraw + eo) = acc[ai][0][m][n]; *(f32x4*)(eraw + eo + DFF) = acc[ai][1][m][n];
                        *(f32x4*)(epart + eo) = a; *(f32x4*)(epart + eo + DFF) = g;
                    }
                }
            }
        }
    }
};

struct TrDesc { const float* W; bf16* WT; int K, N, item, up, wide; };
DI void tr_load(float (&tv)[64], const TrDesc& t, int lane) {
    if (t.wide) {
        const int nblk = t.N / 64, kb = t.item / nblk, nb = t.item % nblk, k0 = 64 * kb, n0 = 64 * nb;
        const float* p = t.W + (size_t)(k0 + (lane >> 4)) * t.N + n0 + (lane & 15) * 4;
#pragma unroll
        for (int i = 0; i < 16; ++i) { const f32x4 v = __builtin_nontemporal_load((const f32x4*)(p + (size_t)(4 * i) * t.N)); tv[4 * i] = v.x; tv[4 * i + 1] = v.y; tv[4 * i + 2] = v.z; tv[4 * i + 3] = v.w; }
    } else {
        const int nblk = t.N / 32, kb = t.item / nblk, nb = t.item % nblk, k0 = 64 * kb, n0 = 32 * nb;
        const float* p = t.W + (size_t)(k0 + (lane >> 5)) * t.N + n0 + (lane & 31);
#pragma unroll
        for (int i = 0; i < 32; ++i) { tv[i] = __builtin_nontemporal_load(p + (size_t)(2 * i) * t.N); tv[32 + i] = 0.f; }
    }
}
DI void tr_store(const float (&tv)[64], const TrDesc& t, LAS float* scr, int lane) {
    if (t.wide) {
        const int nblk = t.N / 64, kb = t.item / nblk, nb = t.item % nblk, k0 = 64 * kb, n0 = 64 * nb;
        const int p0 = !t.up ? n0 : (n0 < DFF ? (n0 >> 7) * 256 + (n0 & 127) : ((n0 - DFF) >> 7) * 256 + 128 + ((n0 - DFF) & 127));
#pragma unroll
        for (int i = 0; i < 16; ++i) { LAS float* s = scr + (4 * i + (lane >> 4)) * 65 + (lane & 15) * 4; s[0] = tv[4 * i]; s[1] = tv[4 * i + 1]; s[2] = tv[4 * i + 2]; s[3] = tv[4 * i + 3]; }
        asm volatile("s_waitcnt lgkmcnt(0)" ::: "memory");
        const int c = lane & 7;
#pragma unroll
        for (int j = 0; j < 8; ++j) { const int n = (lane >> 3) + 8 * j; const LAS float* s = scr + (8 * c) * 65 + n;
            u32x4 o; o.x = pk2(s[0 * 65], s[1 * 65]); o.y = pk2(s[2 * 65], s[3 * 65]); o.z = pk2(s[4 * 65], s[5 * 65]); o.w = pk2(s[6 * 65], s[7 * 65]);
            *(u32x4*)(t.WT + (size_t)(p0 + n) * t.K + k0 + 8 * c) = o; }
        asm volatile("s_waitcnt lgkmcnt(0)" ::: "memory");
    } else {
        const int nblk = t.N / 32, kb = t.item / nblk, nb = t.item % nblk, k0 = 64 * kb, n0 = 32 * nb;
#pragma unroll
        for (int i = 0; i < 32; ++i) { const int kk = 2 * i + (lane >> 5); scr[kk * 33 + (lane & 31)] = tv[i]; }
        asm volatile("s_waitcnt lgkmcnt(0)" ::: "memory");
        const int c = lane & 7;
#pragma unroll
        for (int j = 0; j < 4; ++j) { const int n = (lane >> 3) + 8 * j; const LAS float* s = scr + (8 * c) * 33 + n;
            u32x4 o; o.x = pk2(s[0 * 33], s[1 * 33]); o.y = pk2(s[2 * 33], s[3 * 33]); o.z = pk2(s[4 * 33], s[5 * 33]); o.w = pk2(s[6 * 33], s[7 * 33]);
            *(u32x4*)(t.WT + (size_t)(n0 + n) * t.K + k0 + 8 * c) = o; }
        asm volatile("s_waitcnt lgkmcnt(0)" ::: "memory");
    }
}
DI void p0_mods_item(const Params& P, LAS float* sl, int item, int tid) {
    const int l = item / 96, n0 = (item % 96) * 128;
    LAS float* red = sl + 5 * 2048;
    for (int i = tid; i < 5 * 2048; i += 512) { const int v = i >> 11, k = i & 2047; const float cv = v == 0 ? P.c_ctx[k] : P.c[(v - 1) * 2048 + k]; sl[i] = silu(cv); }
    __syncthreads();
    const int cq = tid & 31, ks = tid >> 5;
    const float* W = P.w_ada + (size_t)l * 2048 * NMODS + n0 + cq * 4;
    f32x4 a0 = {0, 0, 0, 0}, a1 = a0, a2 = a0, a3 = a0, a4 = a0;
#pragma unroll 1
    for (int kb = ks * 128; kb < ks * 128 + 128; kb += 32) {
        f32x4 w[32];
#pragma unroll
        for (int i = 0; i < 32; ++i) w[i] = __builtin_nontemporal_load((const f32x4*)(W + (size_t)(kb + i) * NMODS));
#pragma unroll
        for (int i = 0; i < 32; ++i) { const int k = kb + i; a0 += w[i] * sl[k]; a1 += w[i] * sl[2048 + k]; a2 += w[i] * sl[4096 + k]; a3 += w[i] * sl[6144 + k]; a4 += w[i] * sl[8192 + k]; }
    }
    *(LAS f32x4*)(red + (ks * 5 + 0) * 128 + cq * 4) = a0; *(LAS f32x4*)(red + (ks * 5 + 1) * 128 + cq * 4) = a1; *(LAS f32x4*)(red + (ks * 5 + 2) * 128 + cq * 4) = a2;
    *(LAS f32x4*)(red + (ks * 5 + 3) * 128 + cq * 4) = a3; *(LAS f32x4*)(red + (ks * 5 + 4) * 128 + cq * 4) = a4;
    __syncthreads();
    float* mods = (float*)(P.ws + WS_MODS);
    for (int o = tid; o < 640; o += 512) { const int v = o >> 7, cc = o & 127; float s = P.b_ada[l * NMODS + n0 + cc];
        for (int k2 = 0; k2 < 16; ++k2) s += red[(k2 * 5 + v) * 128 + cc];
        mods[(size_t)(l * 5 + v) * NMODS + n0 + cc] = s; }
    __syncthreads();
}
DI void p0_prologue(const Params& P, LAS unsigned char* lds, int tid, int wave, int lane, int part = 0) {
    const int G = gridDim.x, bx = blockIdx.x;
    if (part != 2) for (int it = bx; it < 192; it += G) p0_mods_item(P, (LAS float*)lds, it, tid);
    const int gt = bx * 512 + tid, NT = G * 512;
    {
        float2* rope = (float2*)(P.ws + WS_ROPE);
        for (int i = gt; i < 2048; i += NT) {
            const int pos = i >> 5, f = i & 31; double fr = 1.0; for (int q = 0; q < f; ++q) fr *= 0.74989420933245582730;
            const float ang = (float)pos * (float)fr;
            double x = (double)ang; const double k = __builtin_rint(x * 0.15915494309189533577); x -= k * 6.28318530717958647692;
            const double x2 = x * x; double sn = 0.0, cs = 0.0;
            double term = x; sn = x; for (int t = 1; t < 16; ++t) { term *= -x2 / (double)((2 * t) * (2 * t + 1)); sn += term; }
            term = 1.0; cs = 1.0; for (int t = 1; t < 16; ++t) { term *= -x2 / (double)((2 * t - 1) * (2 * t)); cs += term; }
            rope[i] = make_float2((float)cs, (float)sn);
        }
        bf16* ck = (bf16*)(P.ws + WS_CK); bf16* cvt = (bf16*)(P.ws + WS_CVT);
        for (int i = gt; i < 4 * 2 * 2 * 256 * 128; i += NT) {
            { const int d = i & 127, t = (i >> 7) & 255, kvh = (i >> 15) & 1, bl = i >> 16;
              ck[i] = (bf16)f2bf(P.cache_k[((size_t)bl * 256 + t) * 256 + kvh * 128 + d]); }
            { const int t = i & 255, d = (i >> 8) & 127, kvh = (i >> 15) & 1, bl = i >> 16;
              cvt[i] = (bf16)f2bf(P.cache_v[((size_t)bl * 256 + t) * 256 + kvh * 128 + d]); }
        }
    }
    LAS float* scr = (LAS float*)(lds + wave * 16640);
    const int gw = bx * 8 + wave, NGW = G * 8;
    constexpr int I_IN = 32 * 145, I_OUT = 32 * 32, I_UP = 32 * 176, I_DN = 88 * 32, I_L = I_IN + I_OUT + I_UP + I_DN;
    __syncthreads();
    auto decode = [&](int it) -> TrDesc {
        const int l = it / I_L; int r = it % I_L; TrDesc t; t.up = 0; t.wide = 1;
        if (r < I_IN) { t.W = P.w_in + (size_t)l * 2048 * NIN; t.WT = (bf16*)(P.ws + WS_WIN) + (size_t)l * NINP * 2048; t.K = 2048; t.N = NIN; t.item = r; t.wide = 0; return t; } r -= I_IN;
        if (r < I_OUT) { t.W = P.w_out + (size_t)l * 2048 * 2048; t.WT = (bf16*)(P.ws + WS_WOUT) + (size_t)l * 2048 * 2048; t.K = 2048; t.N = 2048; t.item = r; return t; } r -= I_OUT;
        if (r < I_UP) { t.W = P.w_up + (size_t)l * 2048 * NUP; t.WT = (bf16*)(P.ws + WS_WUP) + (size_t)l * NUP * 2048; t.K = 2048; t.N = NUP; t.item = r; t.up = 1; return t; } r -= I_UP;
        t.W = P.w_down + (size_t)l * DFF * 2048; t.WT = (bf16*)(P.ws + WS_WDN) + (size_t)l * 2048 * DFF; t.K = DFF; t.N = 2048; t.item = r; return t;
    };
    if (part != 1 && gw < 2 * I_L) {
        float tv[64], tn[64]; { const TrDesc t0 = decode(gw); tr_load(tv, t0, lane); }
        for (int it = gw; it < 2 * I_L; it += NGW) {
            const bool has = it + NGW < 2 * I_L;
            if (has) { const TrDesc nxt = decode(it + NGW); tr_load(tn, nxt, lane); }
            { const TrDesc cur = decode(it); tr_store(tv, cur, scr, lane); }
            if (has) {
#pragma unroll
                for (int i = 0; i < 64; ++i) tv[i] = tn[i]; }
        }
    }
}

template <bool SRC16> DI void row_load(f32x4 (&v)[8], const void* src, int lane) {
#pragma unroll
    for (int j = 0; j < 4; ++j) {
        const int o = (j * 64 + lane) * 8;
        if (SRC16) { const u32x4 t = *(const u32x4*)((const bf16*)src + o);
            v[2 * j].x = bf2f(t.x & 0xffffu); v[2 * j].y = bf2f(t.x >> 16); v[2 * j].z = bf2f(t.y & 0xffffu); v[2 * j].w = bf2f(t.y >> 16);
            v[2 * j + 1].x = bf2f(t.z & 0xffffu); v[2 * j + 1].y = bf2f(t.z >> 16); v[2 * j + 1].z = bf2f(t.w & 0xffffu); v[2 * j + 1].w = bf2f(t.w >> 16); }
        else { v[2 * j] = *(const f32x4*)((const float*)src + o); v[2 * j + 1] = *(const f32x4*)((const float*)src + o + 4); }
    }
}
template <bool DO_LN, bool OUT_F32, bool SRC16>
DI void rows8(const void* src0, size_t src_pitch, const float* lw, const float* lb, const float* sh, const float* sc, void* dst0, int lane, float2* stat) {
    f32x4 A[8], B[8];
#pragma unroll
    for (int j = 0; j < 8; ++j) { const int o = ((j >> 1) * 64 + lane) * 8 + (j & 1) * 4;
        f32x4 a = {1.f, 1.f, 1.f, 1.f}, b = {0.f, 0.f, 0.f, 0.f};
        if (lw) { a = *(const f32x4*)(lw + o); b = *(const f32x4*)(lb + o); }
        if (sc) { const f32x4 m = *(const f32x4*)(sc + o) + 1.f; a = a * m; b = b * m + *(const f32x4*)(sh + o); }
        A[j] = a; B[j] = b; }
    f32x4 v[8], vn[8];
    row_load<SRC16>(v, src0, lane);
#pragma unroll 1
    for (int k = 0; k < 8; ++k) {
        if (k < 7) row_load<SRC16>(vn, SRC16 ? (const void*)((const bf16*)src0 + (size_t)(k + 1) * src_pitch) : (const void*)((const float*)src0 + (size_t)(k + 1) * src_pitch), lane);
        if (DO_LN) {
            float s = 0.f;
#pragma unroll
            for (int j = 0; j < 8; ++j) s += (v[j].x + v[j].y) + (v[j].z + v[j].w);
            const float mean = wave_sum(s) * (1.f / DM); float s2 = 0.f;
#pragma unroll
            for (int j = 0; j < 8; ++j) { v[j] = v[j] - mean; s2 += (v[j].x * v[j].x + v[j].y * v[j].y) + (v[j].z * v[j].z + v[j].w * v[j].w); }
            const float rstd = 1.f / sqrtf(wave_sum(s2) * (1.f / DM) + LN_EPS);
            if (stat && lane == 0) stat[k] = make_float2(mean, rstd);
#pragma unroll
            for (int j = 0; j < 8; ++j) v[j] = v[j] * rstd;
        }
#pragma unroll
        for (int j = 0; j < 4; ++j) { const int o = (j * 64 + lane) * 8; const f32x4 h0 = v[2 * j] * A[2 * j] + B[2 * j], h1 = v[2 * j + 1] * A[2 * j + 1] + B[2 * j + 1];
            if (OUT_F32) { *(f32x4*)((float*)dst0 + (size_t)k * DM + o) = h0; *(f32x4*)((float*)dst0 + (size_t)k * DM + o + 4) = h1; }
            else { u32x4 w; w.x = pk2(h0.x, h0.y); w.y = pk2(h0.z, h0.w); w.z = pk2(h1.x, h1.y); w.w = pk2(h1.z, h1.w); *(u32x4*)((bf16*)dst0 + (size_t)k * DM + o) = w; } }
#pragma unroll
        for (int j = 0; j < 8; ++j) v[j] = vn[j];
    }
}

DI void conv_fixup(const Params& P, int l, int tid) {
    const float* eraw = (const float*)(P.ws + WS_ERAW); const float* epart = (const float*)(P.ws + WS_EPART); bf16* ACT = (bf16*)(P.ws + WS_ACT);
    const float* cw = P.conv_w + (size_t)l * 3 * NUP;
    const int gt = blockIdx.x * 512 + tid, NT = gridDim.x * 512;
    for (int it = gt; it < 56 * 1408; it += NT) {
        const int ri = it / 1408, ff = (it % 1408) * 4, b = ri / 14, k = ri % 14, jb = k >> 1, side = k & 1;
        const int pmA = 32 + 8 * b + jb, pmB = pmA + 1;
        const int row = side ? pmB * 256 : pmA * 256 + 255;
        const size_t own = (size_t)(side ? pmB * 2 + 0 : pmA * 2 + 1) * NUP + ff, nb = (size_t)(side ? pmA * 2 + 1 : pmB * 2 + 0) * NUP + ff;
        const float* wn = cw + (side ? 0 : 2 * NUP) + ff;
        const f32x4 a = *(const f32x4*)(epart + own) + *(const f32x4*)wn * *(const f32x4*)(eraw + nb);
        const f32x4 g = *(const f32x4*)(epart + own + DFF) + *(const f32x4*)(wn + DFF) * *(const f32x4*)(eraw + nb + DFF);
        u32x2 w; w.x = pk2(silu(g[0]) * a[0], silu(g[1]) * a[1]); w.y = pk2(silu(g[2]) * a[2], silu(g[3]) * a[3]);
        *(u32x2*)(ACT + (size_t)row * DFF + ff) = w;
    }
}

DI void gla_finalize(LAS unsigned char* lds, const Params& P, int l, int tid, int wave, int lane) {
    const bf16* src[4] = {(const bf16*)(P.ws + WS_OFB), (const bf16*)(P.ws + WS_OFB) + (size_t)MTOK * 1024, (const bf16*)(P.ws + WS_OINT), (const bf16*)(P.ws + WS_OINT) + (size_t)MTOK * 1024};
    const bf16* proj = (const bf16*)(P.ws + WS_PROJ); bf16* cat = (bf16*)(P.ws + WS_CAT);
    const f32x4 nw = *(const f32x4*)(P.gnw + l * 256 + lane * 4);
    LAS float* T = (LAS float*)lds;
    for (int it = blockIdx.x; it < 1024; it += gridDim.x) {
        const int chunk = it >> 2, h = it & 3, row0 = chunk * 64;
        __syncthreads();
#pragma unroll
        for (int i = 0; i < 4; ++i) {
            const int p = tid + 512 * i, v = p >> 3, c8 = p & 7; const size_t go = (size_t)(h * 256 + v) * MTOK + row0 + c8 * 8;
            const bf16x8 a = *(const bf16x8*)(src[0] + go), b = *(const bf16x8*)(src[1] + go), cc = *(const bf16x8*)(src[2] + go), dd = *(const bf16x8*)(src[3] + go);
#pragma unroll
            for (int e = 0; e < 8; ++e) T[(8 * c8 + e) * 257 + v] = (bf2f((unsigned short)a[e]) + bf2f((unsigned short)cc[e])) + (bf2f((unsigned short)b[e]) + bf2f((unsigned short)dd[e]));
        }
        __syncthreads();
#pragma unroll 2
        for (int tk = 0; tk < 8; ++tk) {
            const int tok = wave * 8 + tk, row = row0 + tok;
            f32x4 o; o.x = T[tok * 257 + lane * 4]; o.y = T[tok * 257 + lane * 4 + 1]; o.z = T[tok * 257 + lane * 4 + 2]; o.w = T[tok * 257 + lane * 4 + 3];
            const u32x2 gg = *(const u32x2*)(proj + (size_t)row * PJP + 2304 + h * 256 + lane * 4);
            const float ss = wave_sum((o.x * o.x + o.y * o.y) + (o.z * o.z + o.w * o.w));
            const float rstd = 1.f / sqrtf(ss * (1.f / 256.f) + LN_EPS);
            f32x4 g; g.x = silu(bf2f(gg.x & 0xffffu)); g.y = silu(bf2f(gg.x >> 16)); g.z = silu(bf2f(gg.y & 0xffffu)); g.w = silu(bf2f(gg.y >> 16));
            const f32x4 r = o * rstd * nw * g;
            u32x2 w; w.x = pk2(r.x, r.y); w.y = pk2(r.z, r.w);
            *(u32x2*)(cat + (size_t)row * DM + 1024 + h * 256 + lane * 4) = w;
        }
    }
}

DI void rope_pair(bf16x8& a, bf16x8& b, const float2* cs) {
#pragma unroll
    for (int j = 0; j < 8; ++j) { const float x1 = bf2f((unsigned short)a[j]), x2 = bf2f((unsigned short)b[j]); const float2 t = cs[j];
        a[j] = (short)f2bf(x1 * t.x - x2 * t.y); b[j] = (short)f2bf(x1 * t.y + x2 * t.x); }
}
constexpr int AT_KL = 0, AT_VT = 64 * 136 * 2;
DI void attn_unit(LAS unsigned char* lds, const Params& P, int l, int unit, bool latent, int tid_, int wave, int lane_) {
    int tid = tid_, lane = lane_; asm volatile("" : "+v"(tid), "+v"(lane));
    const int r = lane & 31, hh = lane >> 5;
    int b, head, Q0, RB, T;
    if (latent) { b = unit >> 6; head = (unit >> 3) & 7; Q0 = (unit & 7) * 256; RB = CTXR + b * 2048; T = 2048; }
    else { b = unit >> 3; head = unit & 7; Q0 = 0; RB = b * 256; T = 256; }
    const int kvh = head >> 2;
    const bf16* proj = (const bf16*)(P.ws + WS_PROJ);
    const bf16* vtg = (const bf16*)(P.ws + WS_VT);
    const bf16* ck = (const bf16*)(P.ws + WS_CK) + (size_t)(((b * 2 + l) * 2 + kvh) * 256) * 128;
    const bf16* cvt = (const bf16*)(P.ws + WS_CVT) + (size_t)(((b * 2 + l) * 2 + kvh) * 128) * 256;
    const float2* rope = (const float2*)(P.ws + WS_ROPE);
    const int tq = Q0 + 32 * wave + r;
    const size_t qrow = (size_t)(RB + tq);
    bf16x8 qf[8];
#pragma unroll
    for (int s = 0; s < 8; ++s) qf[s] = *(const bf16x8*)(proj + qrow * PJP + head * 128 + 16 * s + 8 * hh);
    if (latent) {
        const float2* rr = rope + (tq >> 6) * 32 + 8 * hh; const float2* rc = rope + (tq & 63) * 32 + 8 * hh;
        rope_pair(qf[0], qf[2], rr); rope_pair(qf[1], qf[3], rr + 16); rope_pair(qf[4], qf[6], rc); rope_pair(qf[5], qf[7], rc + 16);
    }
    const float SC = 0.08838834764831845f * LOG2E;
    float m = P.sink[l * 8 + head] * LOG2E, lsum = 1.f;
    f32x16 O[4];
#pragma unroll
    for (int d = 0; d < 4; ++d)
#pragma unroll
        for (int i = 0; i < 16; ++i) O[d][i] = 0.f;
    int kstart = 0, nloc = 4, ntiles = 4;
    if (latent) { kstart = Q0 - 128 < 0 ? 0 : Q0 - 128; const int kend = Q0 + 384 > T ? T : Q0 + 384; nloc = (kend - kstart) >> 6; ntiles = nloc + 4; }
    const int skey = tid >> 3, ssub = tid & 7, sd0 = 64 * (ssub >> 2) + 8 * (ssub & 3);
    const bf16* kr = (const bf16*)(P.ws + WS_KR);
    bf16x8 pka, pkb, pv0, pv1;
#define ATT_PREFETCH(TI) do { const int ti_ = (TI); const bool cache_ = ti_ >= nloc; const int k0_ = cache_ ? (ti_ - nloc) * 64 : kstart + ti_ * 64; \
        const bf16* kb_ = cache_ ? ck + (size_t)k0_ * 128 : (latent ? kr + (size_t)(RB - CTXR + k0_) * 256 + kvh * 128 : proj + (size_t)(RB + k0_) * PJP + 1024 + kvh * 128); \
        int t_ = tid; asm volatile("" : "+v"(t_)); const int skey_ = t_ >> 3, ssub_ = t_ & 7, sd0_ = 64 * (ssub_ >> 2) + 8 * (ssub_ & 3); \
        const unsigned kp_ = cache_ ? 128u : (latent ? 256u : (unsigned)PJP); const unsigned ko_ = (unsigned)skey_ * kp_ + (unsigned)sd0_; \
        pka = *(const bf16x8*)(kb_ + ko_); pkb = *(const bf16x8*)(kb_ + ko_ + 32u); \
        const bf16* vb_ = cache_ ? cvt + k0_ : vtg + (size_t)(kvh * 128) * MTOK + RB + k0_; const unsigned vp_ = cache_ ? 256u : (unsigned)MTOK; \
        const unsigned vo_ = (unsigned)(t_ >> 3) * vp_ + (unsigned)(t_ & 7) * 8u; \
        pv0 = *(const bf16x8*)(vb_ + vo_); pv1 = *(const bf16x8*)(vb_ + vo_ + 64u * vp_); } while (0)
    ATT_PREFETCH(0);
    for (int ti = 0; ti < ntiles; ++ti) {
        const bool cache = ti >= nloc; const int k0 = cache ? (ti - nloc) * 64 : kstart + ti * 64;
        const bool local = latent && !cache;
        __syncthreads();
        *(LAS bf16x8*)(lds + AT_KL + (skey * 136 + sd0) * 2) = pka; *(LAS bf16x8*)(lds + AT_KL + (skey * 136 + sd0 + 32) * 2) = pkb;
        { const int d_ = tid >> 3, c8_ = tid & 7; *(LAS bf16x8*)(lds + AT_VT + (d_ * 72 + c8_ * 8) * 2) = pv0; *(LAS bf16x8*)(lds + AT_VT + ((d_ + 64) * 72 + c8_ * 8) * 2) = pv1; }
        __syncthreads();
        if (ti + 1 < ntiles) ATT_PREFETCH(ti + 1);
        if (local) { const int tw = Q0 + 32 * wave; if (k0 + 63 < tw - 128 || k0 > tw + 31 + 128) continue; }
        f32x16 st[2];
        __builtin_amdgcn_s_setprio(1);
#pragma unroll
        for (int kb = 0; kb < 2; ++kb) {
#pragma unroll
            for (int i = 0; i < 16; ++i) st[kb][i] = 0.f;
#pragma unroll
            for (int s = 0; s < 8; ++s) { st[kb] = mfma32(lds16(lds + AT_KL + ((32 * kb + r) * 136 + 16 * s + 8 * hh) * 2), qf[s], st[kb]); if ((s & 3) == 3) __builtin_amdgcn_sched_barrier(0); }
        }
        __builtin_amdgcn_s_setprio(0);
        float mx = -3.0e38f;
#pragma unroll
        for (int kb = 0; kb < 2; ++kb)
#pragma unroll
            for (int i = 0; i < 16; ++i) {
                float z = st[kb][i] * SC;
                if (local) { const int kp = k0 + 32 * kb + crow(i, hh); const int dlt = tq - kp; if (dlt > 128 || dlt < -128) z = -1.0e30f; }
                st[kb][i] = z; mx = fmaxf(mx, z);
            }
        mx = fmaxf(mx, __shfl_xor(mx, 32));
        const float mnew = fmaxf(m, mx), alpha = __builtin_amdgcn_exp2f(m - mnew);
        float rs = 0.f;
#pragma unroll
        for (int kb = 0; kb < 2; ++kb)
#pragma unroll
            for (int i = 0; i < 16; ++i) { const float p = __builtin_amdgcn_exp2f(st[kb][i] - mnew); st[kb][i] = p; rs += p; }
        rs += __shfl_xor(rs, 32);
        lsum = lsum * alpha + rs; m = mnew;
#pragma unroll
        for (int d = 0; d < 4; ++d)
#pragma unroll
            for (int i = 0; i < 16; ++i) O[d][i] *= alpha;
        __builtin_amdgcn_s_setprio(1);
#pragma unroll
        for (int kb = 0; kb < 2; ++kb)
#pragma unroll
            for (int s = 0; s < 2; ++s) {
                const bf16x8 pb = pack8(st[kb], s);
#pragma unroll
                for (int d = 0; d < 4; ++d) {
                    const LAS unsigned char* vp = lds + AT_VT + ((32 * d + r) * 72 + 32 * kb + 16 * s + 4 * hh) * 2;
                    O[d] = mfma32(lds8x2(vp, vp + 16), pb, O[d]);
                }
                __builtin_amdgcn_sched_barrier(0);
            }
        __builtin_amdgcn_s_setprio(0);
    }
    const float inv = 1.f / lsum;
    bf16* cat = (bf16*)(P.ws + WS_CAT) + qrow * DM + head * 128;
#pragma unroll
    for (int d = 0; d < 4; ++d)
#pragma unroll
        for (int g = 0; g < 4; ++g) { u32x2 w; w.x = pk2(O[d][4 * g] * inv, O[d][4 * g + 1] * inv); w.y = pk2(O[d][4 * g + 2] * inv, O[d][4 * g + 3] * inv);
            *(u32x2*)(cat + 32 * d + 8 * g + 4 * hh) = w; }
}

constexpr int GL_QE = 0, GL_KE = 17408, GL_KDT = 34816, GL_VT = 52224, GL_LR = 89088, GL_TOT = 93184, GL_DEC = 95232, GL_WG = 95744;
DI void gla_prep(LAS unsigned char* lds, const Params& P, int l, int it, int tid_, int wave, int lane) {
    const int chunk = it >> 3, h = (it >> 1) & 3, dir = it & 1, row0 = 64 * chunk;
    const bf16* proj = (const bf16*)(P.ws + WS_PROJ);
    const bf16* gvt = (const bf16*)(P.ws + WS_GVT) + (size_t)(h * 256) * MTOK;
    const float* lrb = (const float*)(P.ws + WS_LR);
    bf16* ofb = (bf16*)(P.ws + WS_OFB) + (size_t)dir * MTOK * 1024;
    int d = tid_ & 127, qd = tid_ >> 7, r = lane & 31, hh = lane >> 5, tid = tid_;
    asm volatile("" : "+v"(d), "+v"(qd), "+v"(r), "+v"(hh), "+v"(tid));
    LAS float* LRS = (LAS float*)(lds + GL_LR); LAS float* TOT = (LAS float*)(lds + GL_TOT); LAS float* DEC = (LAS float*)(lds + GL_DEC); LAS float* WGL = (LAS float*)(lds + GL_WG);
    LAS bf16* QE = (LAS bf16*)(lds + GL_QE); LAS bf16* KE = (LAS bf16*)(lds + GL_KE); LAS bf16* KDT = (LAS bf16*)(lds + GL_KDT);
    __syncthreads();
    {
        const float* wg = (dir ? P.wgb : P.wgf) + (size_t)l * 16 * 512 + h * 128;
#pragma unroll
        for (int i = 0; i < 4; ++i) { const int e = tid + 512 * i; WGL[e] = wg[(e >> 7) * 512 + (e & 127)]; }
        if (tid < 256) *(LAS f32x4*)(LRS + tid * 4) = *(const f32x4*)(lrb + (size_t)(row0 + (tid >> 2)) * 32 + dir * 16 + (tid & 3) * 4);
#pragma unroll
        for (int i = 0; i < 4; ++i) { const int piece = tid + 512 * i, v = piece >> 3, c8 = piece & 7;
            *(LAS bf16x8*)(lds + GL_VT + (v * 72 + c8 * 8) * 2) = *(const bf16x8*)(gvt + (size_t)v * MTOK + row0 + c8 * 8); }
    }
    const float bgv = (dir ? P.bgb : P.bgf)[l * 512 + h * 128 + d];
    unsigned qk[16];
    { const unsigned voff = (unsigned)(16 * qd * PJP + d);
#pragma unroll
      for (int i = 0; i < 16; ++i) { const bf16* sb = proj + (size_t)(row0 + i) * PJP + h * 128; qk[i] = (unsigned)sb[voff + 1280u] | ((unsigned)sb[voff + 1792u] << 16); } }
    __syncthreads();
    float bl[16];
#pragma unroll
    for (int i = 0; i < 16; ++i) { float x = bgv;
#pragma unroll
        for (int q = 0; q < 16; ++q) x += LRS[(16 * qd + i) * 16 + q] * WGL[q * 128 + d];
        bl[i] = (fminf(x, 0.f) - flog(1.f + fexp(-fabsf(x)))) * 0.0625f; }
    float run = 0.f;
    if (dir == 0) {
#pragma unroll
        for (int i = 0; i < 16; ++i) { run += bl[i]; bl[i] = run; }
    } else {
#pragma unroll
        for (int i = 15; i >= 0; --i) { run += bl[i]; bl[i] = run; }
    }
    TOT[qd * 128 + d] = run;
    __syncthreads();
    const float t0 = TOT[d], t1 = TOT[128 + d], t2 = TOT[256 + d], t3 = TOT[384 + d];
    const float total = (t0 + t1) + (t2 + t3);
    float off;
    if (dir == 0) off = qd == 0 ? 0.f : qd == 1 ? t0 : qd == 2 ? t0 + t1 : t0 + t1 + t2;
    else off = qd == 3 ? 0.f : qd == 2 ? t3 : qd == 1 ? t3 + t2 : t3 + t2 + t1;
    unsigned kdp[8];
#pragma unroll
    for (int i = 0; i < 16; i += 2) {
        const float b0 = bl[i] + off, b1 = bl[i + 1] + off;
        const float e0 = fexp(b0), e1 = fexp(b1);
        const float q0 = bf2f(qk[i] & 0xffffu), k0v = bf2f(qk[i] >> 16), q1 = bf2f(qk[i + 1] & 0xffffu), k1v = bf2f(qk[i + 1] >> 16);
        QE[(16 * qd + i) * 136 + d] = (bf16)f2bf(q0 * 0.08838834764831845f * e0); QE[(16 * qd + i + 1) * 136 + d] = (bf16)f2bf(q1 * 0.08838834764831845f * e1);
        KE[(16 * qd + i) * 136 + d] = (bf16)f2bf(k0v * fexp(-b0)); KE[(16 * qd + i + 1) * 136 + d] = (bf16)f2bf(k1v * fexp(-b1));
        kdp[i >> 1] = pk2(k0v * fexp(total - b0), k1v * fexp(total - b1));
    }
#pragma unroll
    for (int i = 0; i < 4; ++i) { u32x2 w; w.x = kdp[2 * i]; w.y = kdp[2 * i + 1]; *(LAS u32x2*)(KDT + d * 68 + 16 * qd + 4 * i) = w; }
    if (qd == 0) { ((float*)(P.ws + WS_GDEC))[(size_t)it * 128 + d] = fexp(total); }
    __syncthreads();
    {
        bf16* gqe = (bf16*)(P.ws + WS_GQE) + (size_t)it * 8192; bf16* gkd = (bf16*)(P.ws + WS_GKD) + (size_t)it * 8192;
#pragma unroll
        for (int i = 0; i < 2; ++i) { const int p = tid + 512 * i, row = p >> 4, c16 = p & 15; *(bf16x8*)(gqe + row * 128 + c16 * 8) = lds16(lds + GL_QE + (row * 136 + c16 * 8) * 2); }
#pragma unroll
        for (int i = 0; i < 2; ++i) { const int p = tid + 512 * i, row = p >> 3, c8 = p & 7; const LAS unsigned char* s = lds + GL_KDT + (row * 68 + c8 * 8) * 2; *(bf16x8*)(gkd + row * 64 + c8 * 8) = lds8x2(s, s + 8); }
    }
#pragma unroll 1
    for (int ib = 0; ib < 2; ++ib) {
        f32x16 AT[2];
#pragma unroll
        for (int jb = 0; jb < 2; ++jb) {
#pragma unroll
            for (int i = 0; i < 16; ++i) AT[jb][i] = 0.f;
#pragma unroll
            for (int s = 0; s < 8; ++s)
                AT[jb] = mfma32(lds16(lds + GL_KE + ((32 * jb + r) * 136 + 16 * s + 8 * hh) * 2), lds16(lds + GL_QE + ((32 * ib + r) * 136 + 16 * s + 8 * hh) * 2), AT[jb]);
#pragma unroll
            for (int i = 0; i < 16; ++i) { const int j = 32 * jb + crow(i, hh), ii = 32 * ib + r; const bool keep = dir == 0 ? (j <= ii) : (j >= ii); if (!keep) AT[jb][i] = 0.f; }
        }
        f32x16 o;
#pragma unroll
        for (int i = 0; i < 16; ++i) o[i] = 0.f;
#pragma unroll
        for (int jb = 0; jb < 2; ++jb)
#pragma unroll
            for (int s = 0; s < 2; ++s) {
                const LAS unsigned char* vp = lds + GL_VT + ((32 * wave + r) * 72 + 32 * jb + 16 * s + 4 * hh) * 2;
                o = mfma32(lds8x2(vp, vp + 16), pack8(AT[jb], s), o);
            }
        bf16* op = ofb + (size_t)(h * 256 + 32 * wave + 4 * hh) * MTOK + row0 + 32 * ib + r;
#pragma unroll
        for (int i = 0; i < 16; ++i) op[(size_t)((i & 3) + 8 * (i >> 2)) * MTOK] = (bf16)f2bf(o[i]);
    }
}
DI void rope_k_pass(const Params& P, int tid) {
    const bf16* proj = (const bf16*)(P.ws + WS_PROJ); bf16* kr = (bf16*)(P.ws + WS_KR); const float2* rope = (const float2*)(P.ws + WS_ROPE);
    const int gt = blockIdx.x * 512 + tid, NT = gridDim.x * 512;
    for (int it = gt; it < 8192 * 16; it += NT) {
        const int row = it >> 4, sub = it & 15, kvh = sub >> 3, half = (sub >> 2) & 1, c4 = sub & 3, d0 = kvh * 128 + 64 * half + 8 * c4;
        const bf16* src = proj + (size_t)(CTXR + row) * PJP + 1024 + d0;
        bf16x8 a = *(const bf16x8*)src, b = *(const bf16x8*)(src + 32);
        const int t = row & 2047, pos = half ? (t & 63) : (t >> 6);
        rope_pair(a, b, rope + pos * 32 + 8 * c4);
        *(bf16x8*)(kr + (size_t)row * 256 + d0) = a; *(bf16x8*)(kr + (size_t)row * 256 + d0 + 32) = b;
    }
}
DI void gla_chain(LAS unsigned char* lds, const Params& P, int l, int ci, bool latent, int tid_, int wave, int lane, bf16* dump = nullptr) {
    const int b = ci >> 3, h = (ci >> 1) & 3, dir = ci & 1;
    const int RB = latent ? CTXR + b * 2048 : b * 256, NCH = latent ? 32 : 4;
    const bf16* gvt = (const bf16*)(P.ws + WS_GVT) + (size_t)(h * 256) * MTOK;
    bf16* ofb = (bf16*)(P.ws + WS_OINT) + (size_t)dir * MTOK * 1024;
    const bf16* gqe = (const bf16*)(P.ws + WS_GQE); const bf16* gkd = (const bf16*)(P.ws + WS_GKD); const float* gdec = (const float*)(P.ws + WS_GDEC);
    f32x16 S[4];
    {
        const int r = lane & 31, hh = lane >> 5;
        if (latent) {
            const float* s0 = (dir ? P.st_b : P.st_f) + (size_t)(((b * 2 + l) * 4 + h) * 128) * 256 + 32 * wave + r + 1024 * hh;
#pragma unroll
            for (int k = 0; k < 4; ++k) {
                const float* p = s0 + 8192 * k; asm volatile("" : "+v"(p));
#pragma unroll
                for (int i = 0; i < 16; ++i) S[k][i] = p[((i & 3) + 8 * (i >> 2)) * 256];
            }
        } else {
#pragma unroll
            for (int k = 0; k < 4; ++k)
#pragma unroll
                for (int i = 0; i < 16; ++i) S[k][i] = 0.f;
        }
    }
    LAS float* DEC = (LAS float*)(lds + GL_DEC);
    struct Pre { bf16x8 q0, q1, k0, k1, v[4]; float dec; };
    Pre A, B; A.dec = 0.f; B.dec = 0.f;
#define GLA_PREFETCH(X, STEP) do { const int c_ = dir ? NCH - 1 - (STEP) : (STEP), row0_ = RB + 64 * c_; const size_t it_ = (size_t)(((row0_ >> 6) * 4 + h) * 2 + dir); \
        const bf16* q_ = gqe + it_ * 8192; const bf16* k_ = gkd + it_ * 8192; int t_ = tid_; asm volatile("" : "+v"(t_)); const unsigned to_ = (unsigned)t_ * 8u; \
        X.q0 = *(const bf16x8*)(q_ + to_); X.q1 = *(const bf16x8*)(q_ + (to_ + 4096u)); X.k0 = *(const bf16x8*)(k_ + to_); X.k1 = *(const bf16x8*)(k_ + (to_ + 4096u)); \
        const bf16* v_ = gvt + row0_; const unsigned vo_ = (unsigned)(t_ >> 3) * (unsigned)MTOK + (unsigned)(t_ & 7) * 8u; \
        _Pragma("unroll") for (int i_ = 0; i_ < 4; ++i_) X.v[i_] = *(const bf16x8*)(v_ + (vo_ + (unsigned)(64 * i_) * (unsigned)MTOK)); \
        if (t_ < 128) X.dec = gdec[it_ * 128 + (unsigned)t_]; } while (0)
#define GLA_STEP(X, STEP) do { const int step = (STEP); const int c = dir ? NCH - 1 - step : step, row0 = RB + 64 * c; \
        int r = lane & 31, hh = lane >> 5, tid = tid_; \
        asm volatile("" : "+v"(r), "+v"(hh), "+v"(tid)); \
        __syncthreads(); \
        { const int p = tid, row = p >> 4, c16 = p & 15; *(LAS bf16x8*)(lds + GL_QE + (row * 136 + c16 * 8) * 2) = X.q0; *(LAS bf16x8*)(lds + GL_QE + ((row + 32) * 136 + c16 * 8) * 2) = X.q1; } \
        { const int p = tid, row = p >> 3, c8 = p & 7; LAS unsigned char* s0 = lds + GL_KDT + (row * 68 + c8 * 8) * 2; LAS unsigned char* s1 = lds + GL_KDT + ((row + 64) * 68 + c8 * 8) * 2; \
          const u32x4 w0 = __builtin_bit_cast(u32x4, X.k0), w1 = __builtin_bit_cast(u32x4, X.k1); \
          *(LAS u32x2*)s0 = (u32x2){w0.x, w0.y}; *(LAS u32x2*)(s0 + 8) = (u32x2){w0.z, w0.w}; *(LAS u32x2*)s1 = (u32x2){w1.x, w1.y}; *(LAS u32x2*)(s1 + 8) = (u32x2){w1.z, w1.w}; } \
        _Pragma("unroll") for (int i = 0; i < 4; ++i) { const int piece = tid + 512 * i; *(LAS bf16x8*)(lds + GL_VT + ((piece >> 3) * 72 + (piece & 7) * 8) * 2) = X.v[i]; } \
        if (tid < 128) DEC[tid] = X.dec; \
        __syncthreads(); \
        if (step + 2 < NCH) GLA_PREFETCH(X, step + 2); \
        { f32x16 o0, o1, o2, o3; \
          _Pragma("unroll") for (int i = 0; i < 16; ++i) { o0[i] = 0.f; o1[i] = 0.f; o2[i] = 0.f; o3[i] = 0.f; } \
          _Pragma("unroll") for (int k = 0; k < 4; k += 2) \
            _Pragma("unroll") for (int s = 0; s < 2; ++s) {     \
                const LAS unsigned char* qa = lds + GL_QE + ((r) * 136 + 32 * k + 16 * s + 4 * hh) * 2; const LAS unsigned char* qb = qa + 32 * 136 * 2; \
                const bf16x8 sa = pack8(S[k], s), sb = pack8(S[k + 1], s); \
                o0 = mfma32(sa, lds8x2(qa, qa + 16), o0); o1 = mfma32(sa, lds8x2(qb, qb + 16), o1); \
                o2 = mfma32(sb, lds8x2(qa + 64, qa + 80), o2); o3 = mfma32(sb, lds8x2(qb + 64, qb + 80), o3); } \
          bf16* op = (dump ? dump : ofb) + (size_t)(h * 256 + 32 * wave + 4 * hh) * MTOK + row0 + r; \
          _Pragma("unroll") for (int i = 0; i < 16; ++i) { op[(size_t)((i & 3) + 8 * (i >> 2)) * MTOK] = (bf16)f2bf(o0[i] + o2[i]); op[(size_t)((i & 3) + 8 * (i >> 2)) * MTOK + 32] = (bf16)f2bf(o1[i] + o3[i]); } } \
        _Pragma("unroll") for (int k = 0; k < 4; ++k) { \
            _Pragma("unroll") for (int g = 0; g < 4; ++g) { const f32x4 dv = *(const LAS f32x4*)(DEC + 32 * k + 8 * g + 4 * hh); \
                S[k][4 * g] *= dv.x; S[k][4 * g + 1] *= dv.y; S[k][4 * g + 2] *= dv.z; S[k][4 * g + 3] *= dv.w; } } \
        _Pragma("unroll") for (int s = 0; s < 4; ++s) { \
            const bf16x8 vb = lds16(lds + GL_VT + ((32 * wave + r) * 72 + 16 * s + 8 * hh) * 2); \
            _Pragma("unroll") for (int k = 0; k < 4; ++k) {     \
                const LAS unsigned char* kp = lds + GL_KDT + ((32 * k + r) * 68 + 16 * s + 8 * hh) * 2; \
                S[k] = mfma32(lds8x2(kp, kp + 8), vb, S[k]); } } } while (0)
    GLA_PREFETCH(A, 0); GLA_PREFETCH(B, 1);
#pragma unroll 1
    for (int st2 = 0; st2 < NCH; st2 += 2) { GLA_STEP(A, st2); GLA_STEP(B, st2 + 1); }
#undef GLA_STEP
#undef GLA_PREFETCH
    if (!latent) {
        const int r = lane & 31, hh = lane >> 5;
        float* dst = P.out + (dir ? OUT_SB : OUT_SF) + (size_t)(((b * 2 + l) * 4 + h) * 128) * 256 + 32 * wave + r + 1024 * hh;
#pragma unroll
        for (int k = 0; k < 4; ++k) {
            float* p = dst + 8192 * k; asm volatile("" : "+v"(p));
#pragma unroll
            for (int i = 0; i < 16; ++i) p[((i & 3) + 8 * (i >> 2)) * 256] = S[k][i];
        }
    }
}

#ifndef ONLY
#define SEL(k) true
#else
#define SEL(k) (ONLY == (k))
#endif
DI void run_phase(const Params& P, LAS unsigned char* lds, int ph, int tid, int wave, int lane, int rep = 0) {
    const int G = gridDim.x, bx = blockIdx.x;
    const int gw = bx * 8 + wave, NGW = G * 8;
    bf16* H = (bf16*)(P.ws + WS_H); bf16* XY = (bf16*)(P.ws + WS_XY);
    if (SEL(100) && ph == 0) { p0_prologue(P, lds, tid, wave, lane, rep); return; }
    if (SEL(101) && ph == 1) {
        if (gw < MTOK / 8) {   const int row = gw * 8; const float* md = mods_ptr(P, 0, mv_of_row(row));
            rows8<false, false, false>(row < CTXR ? P.xp + (size_t)row * DM : P.xs + (size_t)(row - CTXR) * DM, DM, nullptr, nullptr, md, md + 2048, H + (size_t)row * DM, lane, nullptr); }
        return;
    }
    const int l = (ph - 2) / NSUB, sub_ = (ph - 2) % NSUB;
    const int sub = sub_ == 0 ? 0 : sub_ == 1 ? 99 : sub_ == 2 ? 1 : sub_ == 3 ? 2 : sub_ == 4 ? 3 : sub_ == 5 ? 4 : sub_ == 6 ? 5 : sub_ == 7 ? 6 : sub_ == 8 ? 9 : 10;
    if (sub_ == 1) {
        rope_k_pass(P, tid);
        for (int it = bx; it < 2048; it += G) gla_prep(lds, P, l, it, tid, wave, lane);
        return;
    }
    if (SEL(0) && sub == 0) {
        pg8::Gemm g{H, (const bf16*)(P.ws + WS_WIN) + (size_t)l * NINP * 2048, MTOK, NINP, 2048}; pg8::StaticOrder S; S.init(MTOK, NINP, G, bx);
        EpiIn E{(bf16*)(P.ws + WS_PROJ), (float*)(P.ws + WS_LR), (bf16*)(P.ws + WS_VT), (bf16*)(P.ws + WS_GVT), P.out + OUT_K + (size_t)l * 65536, P.out + OUT_V + (size_t)l * 65536};
        pg8::gemm_phase<EpiIn, pg8::StaticOrder, false, true>(lds, g, S, E, wave, tid);
    } else if (SEL(1) && sub == 1) {
        unsigned* ctr = (unsigned*)(P.ws + WS_CTL) + 64 * (l + 2 * rep);
        LAS int* slot = (LAS int*)(lds + LDS_BYTES - 64);
        for (;;) {
            __syncthreads();
            if (tid == 0) *slot = (int)atomicAdd(ctr, 1u);
            __syncthreads();
            const int item = __builtin_amdgcn_readfirstlane(*slot);
            if (item >= 800) break;
#ifdef REP_LO
            if (rep && (item < REP_LO || item >= REP_HI)) continue;
#endif
#ifndef NO_GLA
            if (item < 32 || (item >= 288 && item < 544)) gla_chain(lds, P, l, item < 32 ? item : item - 288, item < 32, tid, wave, lane, rep ? (bf16*)P.out : nullptr);
#endif
#ifndef NO_ATT
            if ((item >= 32 && item < 288) || item >= 544) attn_unit(lds, P, l, item < 288 ? item - 32 : item - 544, item < 288, tid, wave, lane);
#endif
        }
    } else if (SEL(2) && sub == 2) {
        gla_finalize(lds, P, l, tid, wave, lane);
    } else if (SEL(3) && (sub == 3 || sub == 9)) {
        const bool dn = sub == 9;
        pg8::Gemm g{dn ? (const bf16*)(P.ws + WS_ACT) : (const bf16*)(P.ws + WS_CAT),
                    dn ? (const bf16*)(P.ws + WS_WDN) + (size_t)l * 2048 * DFF : (const bf16*)(P.ws + WS_WOUT) + (size_t)l * 2048 * 2048, MTOK, 2048, dn ? DFF : 2048};
        pg8::StaticOrder S; S.init(MTOK, 2048, G, bx);
        const bool ext = (!dn && l == 0);
        EpiRes E{P.xp, P.xs, ext ? nullptr : (const bf16*)XY, rep ? (bf16*)P.out : XY, mods_ptr(P, l, 0) + (dn ? 10240 : 4096),
                 (const float2*)(P.ws + WS_STATS), dn ? P.ln1w + l * DM : P.ln2w + (l - 1) * DM, dn ? P.ln1b + l * DM : P.ln2b + (l - 1) * DM};
        pg8::gemm_phase<EpiRes, pg8::StaticOrder, true, true>(lds, g, S, E, wave, tid);
    } else if (SEL(4) && (sub == 4 || sub == 10)) {
        const bool second = sub == 10;
        const float* lw = (second ? P.ln2w : P.ln1w) + l * DM; const float* lb = (second ? P.ln2b : P.ln1b) + l * DM;
        if (rep && second && l == 1) return;
        float2* stats = (float2*)(P.ws + WS_STATS);
        if (gw < MTOK / 8) {   const int row = gw * 8, mv = mv_of_row(row);
            bf16* hd = rep ? (bf16*)(P.out + OUT_K - (size_t)MTOK * DM / 2) + (size_t)row * DM : H + (size_t)row * DM;
            const bf16* src = XY + (size_t)row * DM;
            if (!second) { const float* md = mods_ptr(P, l, mv); rows8<true, false, true>(src, DM, lw, lb, md + 6144, md + 8192, hd, lane, rep ? nullptr : stats + row); }
            else if (l == 0) { const float* md = mods_ptr(P, 1, mv); rows8<true, false, true>(src, DM, lw, lb, md, md + 2048, hd, lane, rep ? nullptr : stats + row); }
            else rows8<true, true, true>(src, DM, lw, lb, nullptr, nullptr, P.out + (size_t)row * DM, lane, nullptr); }
    } else if (SEL(5) && sub == 5) {
        pg8::Gemm g{H, (const bf16*)(P.ws + WS_WUP) + (size_t)l * NUP * 2048, MTOK, NUP, 2048}; pg8::StaticOrder S; S.init(MTOK, NUP, G, bx);
        EpiUpConv E{(bf16*)(P.ws + WS_ACT), (float*)(P.ws + WS_ERAW), (float*)(P.ws + WS_EPART), P.conv_w + (size_t)l * 3 * NUP, P.conv_b + (size_t)l * NUP, (LAS float*)(lds + 131072)};
        pg8::gemm_phase<EpiUpConv, pg8::StaticOrder, true, true>(lds, g, S, E, wave, tid);
    } else if (SEL(6) && sub == 6) {
        conv_fixup(P, l, tid);
    }
}

DI void seam_barrier(unsigned* ctr, unsigned G, int tid) {
    asm volatile("s_waitcnt vmcnt(0) lgkmcnt(0)" ::: "memory");
    __syncthreads();
    if (tid == 0) {
        __builtin_amdgcn_fence(__ATOMIC_RELEASE, "agent");
        asm volatile("s_waitcnt vmcnt(0)" ::: "memory");
        __hip_atomic_fetch_add(ctr, 1u, __ATOMIC_RELAXED, __HIP_MEMORY_SCOPE_AGENT);
        while (__hip_atomic_load(ctr, __ATOMIC_RELAXED, __HIP_MEMORY_SCOPE_AGENT) < G) __builtin_amdgcn_s_sleep(1);
        __builtin_amdgcn_fence(__ATOMIC_ACQUIRE, "agent");
        asm volatile("s_waitcnt vmcnt(0)" ::: "memory");
    }
    __syncthreads();
}
__global__ void __launch_bounds__(512, 2) mega(Params P) {
    extern __shared__ __attribute__((aligned(16))) unsigned char lds_raw[];
    LAS unsigned char* lds = (LAS unsigned char*)lds_raw;
    const int wave = __builtin_amdgcn_readfirstlane((int)threadIdx.x >> 6);
    int ph = P.ph_lo;
    if (ph == 0) {
        const int tid0 = threadIdx.x;
        run_phase(P, lds, 0, tid0, wave, tid0 & 63);
#ifdef DBL_PRO
        __syncthreads(); run_phase(P, lds, 0, tid0, wave, tid0 & 63, DBL_PRO);
#endif
        ++ph;
#if !MK_MULTI
        if (ph < P.ph_hi) cg::this_grid().sync();
#endif
    }
    for (; ph < P.ph_hi; ++ph) {
        int lane; asm volatile("v_mbcnt_lo_u32_b32 %0, -1, 0\n\tv_mbcnt_hi_u32_b32 %0, -1, %0" : "=v"(lane));
        const int tid = wave * 64 + lane;
        if (ph > P.ph_lo && ph > 1) seam_barrier((unsigned*)(P.ws + WS_CTL) + 1024 + 64 * ph, gridDim.x, tid);
        Params Q = P; asm volatile("" : "+s"(Q.ws));
        run_phase(Q, lds, ph, tid, wave, lane);
#ifdef DBL_SUB
        if ((ph >= 2 && ((ph - 2) % NSUB) == DBL_SUB) || (DBL_SUB >= 100 && ph == DBL_SUB - 100)) { seam_barrier((unsigned*)(P.ws + WS_CTL) + 1024 + 64 * (ph + 32), gridDim.x, tid); run_phase(P, lds, ph, tid, wave, lane, 1); }
#endif
    }
}

extern "C" void kernel_launch(void* const* d_in, const int* in_sizes, int n_in, void* d_out, int out_size, void* d_ws, size_t ws_size, hipStream_t stream) {
    static int grid = 0;
    if (grid == 0) {
        if (n_in != 26 || ws_size < WS_END) { fprintf(stderr, "kernel_launch: unexpected n_in %d / ws_size %zu (need %zu)\n", n_in, ws_size, (size_t)WS_END); grid = -1; return; }
        int dev = 0, cus = 0, per_cu = 0;
        if (hipGetDevice(&dev) != hipSuccess || hipDeviceGetAttribute(&cus, hipDeviceAttributeMultiprocessorCount, dev) != hipSuccess) { grid = -1; return; }
        if (hipFuncSetAttribute((const void*)mega, hipFuncAttributeMaxDynamicSharedMemorySize, LDS_BYTES) != hipSuccess) { fprintf(stderr, "kernel_launch: hipFuncSetAttribute failed\n"); grid = -1; return; }
        if (hipOccupancyMaxActiveBlocksPerMultiprocessor(&per_cu, (const void*)mega, 512, LDS_BYTES) != hipSuccess || per_cu < 1) fprintf(stderr, "kernel_launch: occupancy query says %d\n", per_cu);
        (void)hipGetLastError();
        grid = cus;
        if (cus != 256) { fprintf(stderr, "kernel_launch: built for a 256-CU device (got %d)\n", cus); grid = -1; return; }
    }
    if (grid < 0) return;
    (void)hipMemsetAsync((char*)d_ws + WS_CTL, 0, 32768, stream);
    Params p{};
    const float** pp = (const float**)&p;
    for (int i = 0; i < 26; ++i) pp[i] = (const float*)d_in[i];
    p.out = (float*)d_out; p.ws = (unsigned char*)d_ws;
#if MK_MULTI
    for (int ph = 0; ph < NPHASE; ++ph) { p.ph_lo = ph; p.ph_hi = ph + 1; hipLaunchKernelGGL(mega, dim3(grid), dim3(512), LDS_BYTES, stream, p); }
#else
    p.ph_lo = 0; p.ph_hi = NPHASE;
    void* args[] = {&p};
    hipError_t e = hipLaunchCooperativeKernel((const void*)mega, dim3(grid), dim3(512), args, LDS_BYTES, stream);
    if (e != hipSuccess) fprintf(stderr, "cooperative launch failed: %s (grid %d)\n", hipGetErrorString(e), grid);
#endif
}
```

```cpp
#include <hip/hip_runtime.h>
#include <hip/hip_cooperative_groups.h>
#include <cstdio>
#include <cstdint>
namespace cg = cooperative_groups;
namespace pg8 {
#define PG8_LAS __attribute__((address_space(3)))
typedef unsigned short bf16_t;
typedef short bf16x8 __attribute__((ext_vector_type(8)));
typedef float f32x4 __attribute__((ext_vector_type(4)));
typedef unsigned u32x4 __attribute__((ext_vector_type(4)));
constexpr int BM = 256, BK = 64, HALF = 128, HTB = HALF * BK * 2  , STAGE_BYTES = 8 * HTB, NXCD = 8, WGM = 8;

__host__ __device__ __forceinline__ int lds_byte(int r, int c) { const int st = (r >> 4) * 2 + (c >> 5), rr = r & 15, cc = c & 31, ob = rr * 64 + cc * 2; return st * 1024 + (ob ^ (((ob >> 9) & 1) << 5)); }
__host__ __device__ __forceinline__ void stage_rc(int b, int& R, int& C) { const int st = b / 1024, sb = b % 1024, swz = sb ^ (((sb >> 9) & 1) << 5); R = (st >> 1) * 16 + swz / 64; C = (st & 1) * 32 + (swz % 64) / 2; }
__host__ __device__ __forceinline__ int perm32(int rho) { const int n = rho >> 4, i = rho & 15; return 8 * (i >> 2) + 4 * n + (i & 3); }

struct Unit { int pm, pn; };
struct Gemm { const bf16_t* A; const bf16_t* Bt; int M, N, K; };

struct StaticOrder {
    int nM, nN, nwg, G, c;
    __host__ __device__ void init(int M, int N, int G_, int c_) { nM = M / BM; nN = N / BM; nwg = nM * nN; G = G_; c = c_; }
    __host__ __device__ bool next(int i, Unit& u) const {
        const long L = (long)i * G + c; if (L >= nwg) return false;
        int wgid = (int)L; { const int q = nwg / NXCD, r = nwg % NXCD, xcd = wgid % NXCD, off = wgid / NXCD; wgid = (xcd < r ? xcd * (q + 1) : r * (q + 1) + (xcd - r) * q) + off; }
        const int nig = WGM * nN, gid = wgid / nig, fm = gid * WGM, gsz = (nM - fm) < WGM ? (nM - fm) : WGM;
        u.pm = fm + ((wgid % nig) % gsz); u.pn = (wgid % nig) / gsz; return true;
    }
    __device__ __forceinline__ void a_ready(const Unit&) const {}
    __device__ __forceinline__ void done(const Unit&) const {}
};

template <class Epi, class Sched, bool ALIGN_EPI = false, bool SP2 = false>
__device__ __forceinline__ void gemm_phase(PG8_LAS unsigned char* lds, const Gemm g, const Sched& S, const Epi& E, const int wid, const int tid) {
    const int lane = tid & 63, wr = wid >> 2, wc = wid & 3, fr = lane & 15, fq = lane >> 4;
    const int K = g.K, nt = K / BK;
    unsigned voffA[2], voffB[2];
#pragma unroll
    for (int i = 0; i < 2; ++i) { int R, C; stage_rc(tid * 16 + i * 8192, R, C); const int Rb = Epi::PERM ? ((R & ~31) + perm32(R & 31)) : R;
        voffA[i] = (unsigned)(R * K + C) * 2u; voffB[i] = (unsigned)(Rb * K + C) * 2u; }
    const size_t kstep = (size_t)(BK * 2);
    const size_t hstep = (size_t)HALF * K * 2;
    const size_t tstep = 2 * hstep;
    const unsigned ldsw = (unsigned)wid * 1024u;
    const int aoff = lds_byte(wr * 64 + fr, fq * 8), boff = lds_byte(wc * 32 + fr, fq * 8);
#define PG8_SA(b, h) (((b) * 2 + (h)) * HTB)
#define PG8_SB(b, h) ((4 + (b) * 2 + (h)) * HTB)
#define PG8_STAGE(bufoff, gbase, voff) do { _Pragma("unroll") for (int _i = 0; _i < 2; ++_i) \
        __builtin_amdgcn_global_load_lds((const unsigned*)((const char*)(gbase) + (voff)[_i]), (PG8_LAS unsigned*)(lds + (bufoff) + ldsw + _i * 8192), 16, 0, 0); } while (0)
#define PG8_LDA(dst, b, h) do { _Pragma("unroll") for (int m = 0; m < 4; ++m) _Pragma("unroll") for (int k = 0; k < 2; ++k) dst[m][k] = *(const PG8_LAS bf16x8*)(lds + PG8_SA(b, h) + aoff + m * 2048 + k * 1024); } while (0)
#define PG8_LDB(dst, b, h) do { _Pragma("unroll") for (int n = 0; n < 2; ++n) _Pragma("unroll") for (int k = 0; k < 2; ++k) dst[n][k] = *(const PG8_LAS bf16x8*)(lds + PG8_SB(b, h) + boff + n * 2048 + k * 1024); } while (0)
#define PG8_MMA(ai, bj, At, Bt) do { __builtin_amdgcn_s_setprio(1); _Pragma("unroll") for (int m = 0; m < 4; ++m) _Pragma("unroll") for (int n = 0; n < 2; ++n) _Pragma("unroll") for (int k = 0; k < 2; ++k) \
        acc[ai][bj][m][n] = __builtin_amdgcn_mfma_f32_16x16x32_bf16(Bt[n][k], At[m][k], acc[ai][bj][m][n], 0, 0, 0); __builtin_amdgcn_s_setprio(0); } while (0)
#define PG8_WAIT_V(n) asm volatile("s_waitcnt vmcnt(" #n ")" ::: "memory")
#define PG8_WAIT_L(n) asm volatile("s_waitcnt lgkmcnt(" #n ")" ::: "memory")
#define PG8_BAR __builtin_amdgcn_s_barrier()
#define PG8_SCHED __builtin_amdgcn_sched_barrier(0)
    Unit cur, nxt; int ui = 0;
    if (!S.next(0, cur)) return;
    f32x4 acc[2][2][4][2];
#pragma unroll
    for (int a = 0; a < 2; ++a)
#pragma unroll
        for (int b = 0; b < 2; ++b)
#pragma unroll
            for (int m = 0; m < 4; ++m)
#pragma unroll
                for (int n = 0; n < 2; ++n) acc[a][b][m][n] = (f32x4){0.f, 0.f, 0.f, 0.f};
    bf16x8 At[4][2], B0[2][2], B1[2][2];
    const char* cA = (const char*)g.A + (size_t)cur.pm * tstep; const char* cB = (const char*)g.Bt + (size_t)cur.pn * tstep;
    S.a_ready(cur);
    if constexpr (SP2) {
        PG8_STAGE(PG8_SB(0, 0), cB, voffB); PG8_STAGE(PG8_SB(0, 1), cB + hstep, voffB); PG8_STAGE(PG8_SA(0, 0), cA, voffA); PG8_STAGE(PG8_SA(0, 1), cA + hstep, voffA);
        if (wr == 1) PG8_BAR;
        PG8_WAIT_V(2); PG8_BAR;
        PG8_STAGE(PG8_SB(1, 0), cB + kstep, voffB); PG8_STAGE(PG8_SA(1, 0), cA + kstep, voffA); PG8_STAGE(PG8_SB(1, 1), cB + hstep + kstep, voffB);
        PG8_WAIT_V(6); PG8_BAR;
    } else {
        PG8_STAGE(PG8_SB(0, 0), cB, voffB); PG8_STAGE(PG8_SA(0, 0), cA, voffA); PG8_STAGE(PG8_SB(0, 1), cB + hstep, voffB); PG8_STAGE(PG8_SA(0, 1), cA + hstep, voffA);
        if (wr == 1) PG8_BAR;
        PG8_WAIT_V(4); PG8_BAR;
        PG8_STAGE(PG8_SB(1, 0), cB + kstep, voffB); PG8_STAGE(PG8_SA(1, 0), cA + kstep, voffA); PG8_STAGE(PG8_SB(1, 1), cB + hstep + kstep, voffB);
        PG8_WAIT_V(6); PG8_BAR;
    }
    for (;;) {
        const bool has_next = S.next(ui + 1, nxt);
        const char* nA = has_next ? (const char*)g.A + (size_t)nxt.pm * tstep : cA; const char* nB = has_next ? (const char*)g.Bt + (size_t)nxt.pn * tstep : cB;
        for (int t = 0; t < nt; t += 2) {
            const bool last = (t == nt - 2);
            const char* a1 = cA + (size_t)(t + 1) * kstep;
            const char* a2 = last ? nA : cA + (size_t)(t + 2) * kstep; const char* b2 = last ? nB : cB + (size_t)(t + 2) * kstep;
            const char* a3 = a2 + kstep; const char* b3 = b2 + kstep;
            if (last && has_next) S.a_ready(nxt);
            if constexpr (SP2) {
            PG8_LDB(B0, 0, 0); PG8_LDB(B1, 0, 1); PG8_SCHED; PG8_LDA(At, 0, 0); PG8_STAGE(PG8_SA(1, 1), a1 + hstep, voffA);
            PG8_WAIT_V(8); PG8_WAIT_L(0); PG8_BAR; PG8_MMA(0, 0, At, B0); PG8_MMA(0, 1, At, B1); PG8_BAR; PG8_SCHED;
            PG8_LDA(At, 0, 1); PG8_STAGE(PG8_SB(0, 0), b2, voffB); PG8_STAGE(PG8_SB(0, 1), b2 + hstep, voffB); PG8_STAGE(PG8_SA(0, 0), a2, voffA);
            PG8_WAIT_V(8); PG8_WAIT_L(0); PG8_BAR; PG8_MMA(1, 0, At, B0); PG8_MMA(1, 1, At, B1); PG8_BAR; PG8_SCHED;
            PG8_LDB(B0, 1, 0); PG8_LDB(B1, 1, 1); PG8_SCHED; PG8_LDA(At, 1, 0); PG8_STAGE(PG8_SA(0, 1), a2 + hstep, voffA);
            PG8_WAIT_V(8); PG8_WAIT_L(0); PG8_BAR; PG8_MMA(0, 0, At, B0); PG8_MMA(0, 1, At, B1); PG8_BAR; PG8_SCHED;
            PG8_LDA(At, 1, 1); PG8_STAGE(PG8_SB(1, 0), b3, voffB); PG8_STAGE(PG8_SB(1, 1), b3 + hstep, voffB); PG8_STAGE(PG8_SA(1, 0), a3, voffA);
            PG8_WAIT_V(8); PG8_WAIT_L(0); PG8_BAR; PG8_MMA(1, 0, At, B0); PG8_MMA(1, 1, At, B1); PG8_BAR; PG8_SCHED;
            } else {
            PG8_LDB(B0, 0, 0); PG8_SCHED; PG8_LDA(At, 0, 0); PG8_STAGE(PG8_SA(1, 1), a1 + hstep, voffA);
            PG8_WAIT_L(8); PG8_BAR; PG8_WAIT_L(0); PG8_MMA(0, 0, At, B0); PG8_BAR; PG8_SCHED;
            PG8_LDB(B1, 0, 1); PG8_STAGE(PG8_SB(0, 0), b2, voffB);
            PG8_BAR; PG8_WAIT_L(0); PG8_MMA(0, 1, At, B1); PG8_BAR;
            PG8_LDA(At, 0, 1); PG8_STAGE(PG8_SA(0, 0), a2, voffA);
            PG8_BAR; PG8_WAIT_L(0); PG8_MMA(1, 0, At, B0); PG8_BAR; PG8_SCHED;
            PG8_STAGE(PG8_SB(0, 1), b2 + hstep, voffB);
            PG8_WAIT_V(6); PG8_BAR; PG8_MMA(1, 1, At, B1); PG8_BAR;
            PG8_LDB(B0, 1, 0); PG8_SCHED; PG8_LDA(At, 1, 0); PG8_STAGE(PG8_SA(0, 1), a2 + hstep, voffA);
            PG8_WAIT_L(8); PG8_BAR; PG8_WAIT_L(0); PG8_MMA(0, 0, At, B0); PG8_BAR; PG8_SCHED;
            PG8_LDB(B1, 1, 1); PG8_STAGE(PG8_SB(1, 0), b3, voffB);
            PG8_BAR; PG8_WAIT_L(0); PG8_MMA(0, 1, At, B1); PG8_BAR;
            PG8_LDA(At, 1, 1); PG8_STAGE(PG8_SA(1, 0), a3, voffA);
            PG8_BAR; PG8_WAIT_L(0); PG8_MMA(1, 0, At, B0); PG8_BAR; PG8_SCHED;
            PG8_STAGE(PG8_SB(1, 1), b3 + hstep, voffB);
            PG8_WAIT_V(6); PG8_BAR; PG8_MMA(1, 1, At, B1); PG8_BAR;
            }
        }
        if constexpr (ALIGN_EPI) { if (wr == 0) PG8_BAR; }
        if constexpr (!Epi::AFTER_DRAIN) { E(acc, cur, wr, wc, fr, fq); S.done(cur); }
        if (!has_next) break;
#pragma unroll
        for (int a = 0; a < 2; ++a)
#pragma unroll
            for (int b = 0; b < 2; ++b)
#pragma unroll
                for (int m = 0; m < 4; ++m)
#pragma unroll
                    for (int n = 0; n < 2; ++n) acc[a][b][m][n] = (f32x4){0.f, 0.f, 0.f, 0.f};
        cur = nxt; cA = nA; cB = nB; ++ui;
        if constexpr (ALIGN_EPI) { if (wr == 1) PG8_BAR; }
    }
    PG8_WAIT_V(0);
    if constexpr (!ALIGN_EPI) { if (wr == 0) PG8_BAR; }
    PG8_BAR;
    if constexpr (Epi::AFTER_DRAIN) { E.fused(acc, cur, wr, wc, fr, fq, lds, wid, lane); S.done(cur); }
#undef PG8_SA
#undef PG8_SB
#undef PG8_STAGE
#undef PG8_LDA
#undef PG8_LDB
#undef PG8_MMA
#undef PG8_WAIT_V
#undef PG8_WAIT_L
#undef PG8_BAR
#undef PG8_SCHED
}
}

#ifndef MK_MULTI
#define MK_MULTI 0
#endif
#define LAS __attribute__((address_space(3)))
#define DI __device__ __forceinline__
typedef unsigned short bf16;
typedef float f32x4 __attribute__((ext_vector_type(4)));
typedef float f32x16 __attribute__((ext_vector_type(16)));
typedef short bf16x8 __attribute__((ext_vector_type(8)));
typedef short s16x4 __attribute__((ext_vector_type(4)));
typedef unsigned u32x4 __attribute__((ext_vector_type(4)));
typedef unsigned u32x2 __attribute__((ext_vector_type(2)));
typedef float f32x2_t __attribute__((ext_vector_type(2)));
typedef __bf16 bf16x2_t __attribute__((ext_vector_type(2)));

constexpr int MTOK = 16384, DM = 2048, NIN = 4640, NINP = 4864, DFF = 5632, NUP = 11264, NMODS = 12288, CTXR = 8192, PJP = 3328;
constexpr float LN_EPS = 1e-5f, DN_ALPHA = 1.4142135623730951f, LOG2E = 1.4426950408889634f;
constexpr size_t MiB = 1u << 20;
constexpr size_t WS_CTL = 0, WS_MODS = 1 * MiB, WS_ROPE = 2 * MiB, WS_CK = 3 * MiB, WS_CVT = 4 * MiB, WS_WIN = 5 * MiB;
constexpr size_t WS_WOUT = WS_WIN + 38 * MiB, WS_WUP = WS_WOUT + 16 * MiB, WS_WDN = WS_WUP + 88 * MiB, WS_H = WS_WDN + 44 * MiB;
constexpr size_t WS_XY = WS_H + 64 * MiB, WS_REG = WS_XY + 128 * MiB;
constexpr size_t WS_PROJ = WS_REG, WS_LR = WS_PROJ + 104 * MiB, WS_VT = WS_LR + 2 * MiB, WS_GVT = WS_VT + 8 * MiB, WS_OFB = WS_GVT + 32 * MiB, WS_OINT = WS_OFB + 64 * MiB, WS_CAT = WS_OINT + 64 * MiB;
constexpr size_t WS_GDEC = WS_CAT + 64 * MiB, WS_KR = WS_GDEC + 1 * MiB, WS_GQE = WS_H, WS_GKD = WS_H + 32 * MiB;
constexpr size_t WS_ERAW = WS_REG, WS_EPART = WS_REG + 8 * MiB, WS_ACT = WS_REG + 176 * MiB, WS_END = WS_REG + 352 * MiB;
static_assert(WS_KR + 4 * MiB <= WS_END, "ws map");
constexpr size_t WS_STATS = WS_MODS + 512 * 1024;
constexpr size_t OUT_K = 33554432, OUT_V = OUT_K + 4194304, OUT_SF = OUT_V + 4194304, OUT_SB = OUT_SF + 8388608;
constexpr int LDS_BYTES = 147456;
constexpr int NSUB = 10, NPHASE = 2 + 2 * NSUB;

struct Params {
    const float *xp, *xs, *cache_k, *cache_v, *st_f, *st_b, *c, *c_ctx, *w_ada, *b_ada, *w_in, *sink, *wgf, *bgf, *wgb, *bgb, *gnw, *w_out,
        *ln1w, *ln1b, *w_up, *conv_w, *conv_b, *w_down, *ln2w, *ln2b;
    float* out; unsigned char* ws; int ph_lo, ph_hi;
};

DI unsigned f2bf(float f) { unsigned u = __float_as_uint(f); return (u + 0x7fffu + ((u >> 16) & 1u)) >> 16; }
DI float bf2f(unsigned b) { return __uint_as_float(b << 16); }
DI unsigned pk2(float lo, float hi) { f32x2_t v = {lo, hi}; bf16x2_t b = __builtin_convertvector(v, bf16x2_t); return __builtin_bit_cast(unsigned, b); }
DI float fexp(float x) { return __builtin_amdgcn_exp2f(x * LOG2E); }
DI float flog(float x) { return __builtin_amdgcn_logf(x) * 0.6931471805599453f; }
DI float silu(float x) { return x * __builtin_amdgcn_rcpf(1.f + fexp(-x)); }
DI float wave_sum(float v) {
#pragma unroll
    for (int o = 1; o < 64; o <<= 1) v += __shfl_xor(v, o);
    return v;
}
DI int crow(int reg, int hh) { return (reg & 3) + 8 * (reg >> 2) + 4 * hh; }
DI f32x16 mfma32(bf16x8 a, bf16x8 b, f32x16 c) { return __builtin_amdgcn_mfma_f32_32x32x16_bf16(a, b, c, 0, 0, 0); }
DI bf16x8 pack8(const f32x16& x, int s) {
    u32x4 p; p.x = pk2(x[8 * s], x[8 * s + 1]); p.y = pk2(x[8 * s + 2], x[8 * s + 3]); p.z = pk2(x[8 * s + 4], x[8 * s + 5]); p.w = pk2(x[8 * s + 6], x[8 * s + 7]);
    return __builtin_bit_cast(bf16x8, p);
}
DI bf16x8 lds16(const LAS unsigned char* p) { return *(const LAS bf16x8*)p; }
DI bf16x8 lds8x2(const LAS unsigned char* p0, const LAS unsigned char* p1) {
    const s16x4 a = *(const LAS s16x4*)p0, b = *(const LAS s16x4*)p1; return __builtin_shufflevector(a, b, 0, 1, 2, 3, 4, 5, 6, 7);
}
DI const float* mods_ptr(const Params& P, int l, int mv) { return (const float*)(P.ws + WS_MODS) + (size_t)(l * 5 + mv) * NMODS; }
DI int mv_of_row(int row) { return row < CTXR ? 0 : 1 + ((row - CTXR) >> 11); }

struct EpiIn {
    static constexpr bool PERM = true, AFTER_DRAIN = false;
    bf16* proj; float* lr; bf16* vt; bf16* gvt; float* outk; float* outv;
    DI void operator()(const pg8::f32x4 (&acc)[2][2][4][2], const pg8::Unit& u, int wr, int wc, int fr, int fq) const {
        const int pn = u.pn, row0 = u.pm * 256 + wr * 64 + fr, colt = pn * 256 + wc * 32 + fq * 8;
        if (pn == 18) {
            if (wc == 0) {
#pragma unroll
                for (int ai = 0; ai < 2; ++ai)
#pragma unroll
                    for (int m = 0; m < 4; ++m)
#pragma unroll
                        for (int n = 0; n < 2; ++n) *(f32x4*)(lr + (size_t)(row0 + ai * 128 + m * 16) * 32 + fq * 8 + n * 4) = acc[ai][0][m][n];
            }
        } else if (pn == 5 || (pn >= 10 && pn <= 13)) {
            bf16* T = (pn == 5) ? vt : gvt; const int cb = colt - ((pn == 5) ? 1280 : 2560);
#pragma unroll
            for (int ai = 0; ai < 2; ++ai)
#pragma unroll
                for (int bj = 0; bj < 2; ++bj)
#pragma unroll
                    for (int m = 0; m < 4; ++m)
#pragma unroll
                        for (int n = 0; n < 2; ++n) {
                            const int row = row0 + ai * 128 + m * 16, c = cb + bj * 128 + n * 4; const f32x4 v = acc[ai][bj][m][n];
#pragma unroll
                            for (int j = 0; j < 4; ++j) T[(size_t)(c + j) * MTOK + row] = (bf16)f2bf(v[j]);
                            if (pn == 5 && u.pm < 32) *(f32x4*)(outv + (size_t)(row >> 8) * 131072 + (row & 255) * 256 + c) = v;
                        }
        } else {
#pragma unroll
            for (int ai = 0; ai < 2; ++ai)
#pragma unroll
                for (int bj = 0; bj < 2; ++bj)
#pragma unroll
                    for (int m = 0; m < 4; ++m) {
                        const int row = row0 + ai * 128 + m * 16, col = colt + bj * 128; const f32x4 v0 = acc[ai][bj][m][0], v1 = acc[ai][bj][m][1];
                        u32x4 w; w.x = pk2(v0[0], v0[1]); w.y = pk2(v0[2], v0[3]); w.z = pk2(v1[0], v1[1]); w.w = pk2(v1[2], v1[3]);
                        *(u32x4*)(proj + (size_t)row * PJP + (col < 1280 ? col : col < 2560 ? col - 256 : col - 1280)) = w;
                        if (pn == 4 && u.pm < 32) { float* ok = outk + (size_t)(row >> 8) * 131072 + (row & 255) * 256 + (col - 1024); *(f32x4*)ok = v0; *(f32x4*)(ok + 4) = v1; }
                    }
        }
    }
};
struct EpiRes {
    static constexpr bool PERM = true, AFTER_DRAIN = false;
    const float* xa; const float* xb; const bf16* yin; bf16* y; const float* gate; const float2* stats; const float* lnw; const float* lnb;
    DI void operator()(const pg8::f32x4 (&acc)[2][2][4][2], const pg8::Unit& u, int wr, int wc, int fr, int fq) const {
        asm volatile("" : "+v"(fr), "+v"(fq));
        const int row0 = u.pm * 256 + wr * 64 + fr, colp = u.pn * 256 + wc * 32 + fq * 8;
        const int mv = u.pm < 32 ? 0 : 1 + ((u.pm - 32) >> 3);
        const float* g = gate + (size_t)mv * NMODS;
        const float* xbase = u.pm < 32 ? xa : xb - (size_t)CTXR * DM;
        float2 st[2][4];
#pragma unroll
        for (int ai = 0; ai < 2; ++ai)
#pragma unroll
            for (int m = 0; m < 4; ++m) st[ai][m] = yin ? stats[row0 + ai * 128 + m * 16] : make_float2(0.f, 1.f);
#pragma unroll
        for (int bj = 0; bj < 2; ++bj) {
            const int col = colp + bj * 128;
            const f32x4 gv0 = *(const f32x4*)(g + col), gv1 = *(const f32x4*)(g + col + 4);
            f32x4 lw0 = {1.f, 1.f, 1.f, 1.f}, lw1 = lw0, lb0 = {0.f, 0.f, 0.f, 0.f}, lb1 = lb0;
            if (yin) { lw0 = *(const f32x4*)(lnw + col); lw1 = *(const f32x4*)(lnw + col + 4); lb0 = *(const f32x4*)(lnb + col); lb1 = *(const f32x4*)(lnb + col + 4); }
#pragma unroll
            for (int ai = 0; ai < 2; ++ai)
#pragma unroll
                for (int m = 0; m < 4; ++m) {
                    const size_t o = (size_t)(row0 + ai * 128 + m * 16) * DM + col;
                    f32x4 x0, x1;
                    if (yin) { const u32x4 t = *(const u32x4*)(yin + o);
                        x0.x = bf2f(t.x & 0xffffu); x0.y = bf2f(t.x >> 16); x0.z = bf2f(t.y & 0xffffu); x0.w = bf2f(t.y >> 16);
                        x1.x = bf2f(t.z & 0xffffu); x1.y = bf2f(t.z >> 16); x1.z = bf2f(t.w & 0xffffu); x1.w = bf2f(t.w >> 16);
                        x0 = (x0 - st[ai][m].x) * st[ai][m].y * lw0 + lb0; x1 = (x1 - st[ai][m].x) * st[ai][m].y * lw1 + lb1; }
                    else { x0 = *(const f32x4*)(xbase + o); x1 = *(const f32x4*)(xbase + o + 4); }
                    const f32x4 r0 = x0 * DN_ALPHA + gv0 * acc[ai][bj][m][0], r1 = x1 * DN_ALPHA + gv1 * acc[ai][bj][m][1];
                    u32x4 w; w.x = pk2(r0.x, r0.y); w.y = pk2(r0.z, r0.w); w.z = pk2(r1.x, r1.y); w.w = pk2(r1.z, r1.w);
                    *(u32x4*)(y + o) = w;
                }
        }
    }
};
template <int CTRL> DI float dppm(float old, float v) { return __builtin_bit_cast(float, __builtin_amdgcn_update_dpp(__builtin_bit_cast(int, old), __builtin_bit_cast(int, v), CTRL, 0xf, 0xf, false)); }
struct EpiUpConv {
    static constexpr bool PERM = true, AFTER_DRAIN = false;
    bf16* ACT; float* eraw; float* epart; const float* cw; const float* cb; LAS float* xl;
    DI void operator()(const pg8::f32x4 (&acc)[2][2][4][2], const pg8::Unit& u, int wr, int wc, int fr, int fq) const {
        asm volatile("" : "+v"(fr), "+v"(fq));
#pragma unroll
        for (int ai = 0; ai < 2; ++ai)
#pragma unroll
            for (int bj = 0; bj < 2; ++bj)
#pragma unroll
                for (int n = 0; n < 2; ++n) {
                    const int col = wc * 32 + fq * 8 + n * 4, s = 2 * ai + wr;
                    if (fr == 0) *(LAS f32x4*)(xl + ((s * 2 + 0) * 2 + bj) * 128 + col) = acc[ai][bj][0][n];
                    if (fr == 15) *(LAS f32x4*)(xl + ((s * 2 + 1) * 2 + bj) * 128 + col) = acc[ai][bj][3][n];
                }
        asm volatile("s_waitcnt lgkmcnt(0)" ::: "memory"); __builtin_amdgcn_s_barrier(); asm volatile("" ::: "memory");
#pragma unroll
        for (int n = 0; n < 2; ++n) {
            const int colw = wc * 32 + fq * 8 + n * 4, ffc = u.pn * 128 + colw;
            f32x4 w0[2], w1[2], w2[2], bb[2];
#pragma unroll
            for (int bj = 0; bj < 2; ++bj) { const int c = ffc + bj * DFF; w0[bj] = *(const f32x4*)(cw + c); w1[bj] = *(const f32x4*)(cw + NUP + c); w2[bj] = *(const f32x4*)(cw + 2 * NUP + c); bb[bj] = *(const f32x4*)(cb + c); }
#pragma unroll
            for (int ai = 0; ai < 2; ++ai) {
                const int s = 2 * ai + wr;
                f32x4 top[2], bot[2];
#pragma unroll
                for (int bj = 0; bj < 2; ++bj) {
                    top[bj] = (f32x4){0.f, 0.f, 0.f, 0.f}; bot[bj] = top[bj];
                    if (s > 0) top[bj] = *(const LAS f32x4*)(xl + (((s - 1) * 2 + 1) * 2 + bj) * 128 + colw);
                    if (s < 3) bot[bj] = *(const LAS f32x4*)(xl + (((s + 1) * 2 + 0) * 2 + bj) * 128 + colw);
                }
#pragma unroll
                for (int m = 0; m < 4; ++m) {
                    f32x4 pre[2];
#pragma unroll
                    for (int bj = 0; bj < 2; ++bj)
#pragma unroll
                        for (int j = 0; j < 4; ++j) {
                            const float v = acc[ai][bj][m][n][j];
                            const float oldu = m > 0 ? dppm<0x121>(0.f, acc[ai][bj][m > 0 ? m - 1 : 0][n][j]) : top[bj][j];
                            const float oldd = m < 3 ? dppm<0x12F>(0.f, acc[ai][bj][m < 3 ? m + 1 : 3][n][j]) : bot[bj][j];
                            const float up = dppm<0x111>(oldu, v), dn = dppm<0x101>(oldd, v);
                            pre[bj][j] = w0[bj][j] * up + w1[bj][j] * v + w2[bj][j] * dn + bb[bj][j];
                        }
                    const int row = u.pm * 256 + ai * 128 + wr * 64 + m * 16 + fr;
                    const f32x4 a = pre[0], g = pre[1];
                    u32x2 w; w.x = pk2(silu(g[0]) * a[0], silu(g[1]) * a[1]); w.y = pk2(silu(g[2]) * a[2], silu(g[3]) * a[3]);
                    *(u32x2*)(ACT + (size_t)row * DFF + ffc) = w;
                    const bool etop = (ai == 0 && m == 0 && wr == 0 && fr == 0), ebot = (ai == 1 && m == 3 && wr == 1 && fr == 15);
                    if (etop || ebot) {
                        const size_t eo = (size_t)(u.pm * 2 + (ebot ? 1 : 0)) * NUP + ffc;
                        *(f32x4*)(eraw + eo) = acc[ai][0][m][n]; *(f32x4*)(eraw + eo + DFF) = acc[ai][1][m][n];
                        *(f32x4*)(epart + eo) = a; *(f32x4*)(epart + eo + DFF) = g;
                    }
                }
            }
        }
    }
};

struct TrDesc { const float* W; bf16* WT; int K, N, item, up, wide; };
DI void tr_load(float (&tv)[64], const TrDesc& t, int lane) {
    if (t.wide) {
        const int nblk = t.N / 64, kb = t.item / nblk, nb = t.item % nblk, k0 = 64 * kb, n0 = 64 * nb;
        const float* p = t.W + (size_t)(k0 + (lane >> 4)) * t.N + n0 + (lane & 15) * 4;
#pragma unroll
        for (int i = 0; i < 16; ++i) { const f32x4 v = __builtin_nontemporal_load((const f32x4*)(p + (size_t)(4 * i) * t.N)); tv[4 * i] = v.x; tv[4 * i + 1] = v.y; tv[4 * i + 2] = v.z; tv[4 * i + 3] = v.w; }
    } else {
        const int nblk = t.N / 32, kb = t.item / nblk, nb = t.item % nblk, k0 = 64 * kb, n0 = 32 * nb;
        const float* p = t.W + (size_t)(k0 + (lane >> 5)) * t.N + n0 + (lane & 31);
#pragma unroll
        for (int i = 0; i < 32; ++i) { tv[i] = __builtin_nontemporal_load(p + (size_t)(2 * i) * t.N); tv[32 + i] = 0.f; }
    }
}
DI void tr_store(const float (&tv)[64], const TrDesc& t, LAS float* scr, int lane) {
    if (t.wide) {
        const int nblk = t.N / 64, kb = t.item / nblk, nb = t.item % nblk, k0 = 64 * kb, n0 = 64 * nb;
        const int p0 = !t.up ? n0 : (n0 < DFF ? (n0 >> 7) * 256 + (n0 & 127) : ((n0 - DFF) >> 7) * 256 + 128 + ((n0 - DFF) & 127));
#pragma unroll
        for (int i = 0; i < 16; ++i) { LAS float* s = scr + (4 * i + (lane >> 4)) * 65 + (lane & 15) * 4; s[0] = tv[4 * i]; s[1] = tv[4 * i + 1]; s[2] = tv[4 * i + 2]; s[3] = tv[4 * i + 3]; }
        asm volatile("s_waitcnt lgkmcnt(0)" ::: "memory");
        const int c = lane & 7;
#pragma unroll
        for (int j = 0; j < 8; ++j) { const int n = (lane >> 3) + 8 * j; const LAS float* s = scr + (8 * c) * 65 + n;
            u32x4 o; o.x = pk2(s[0 * 65], s[1 * 65]); o.y = pk2(s[2 * 65], s[3 * 65]); o.z = pk2(s[4 * 65], s[5 * 65]); o.w = pk2(s[6 * 65], s[7 * 65]);
            *(u32x4*)(t.WT + (size_t)(p0 + n) * t.K + k0 + 8 * c) = o; }
        asm volatile("s_waitcnt lgkmcnt(0)" ::: "memory");
    } else {
        const int nblk = t.N / 32, kb = t.item / nblk, nb = t.item % nblk, k0 = 64 * kb, n0 = 32 * nb;
#pragma unroll
        for (int i = 0; i < 32; ++i) { const int kk = 2 * i + (lane >> 5); scr[kk * 33 + (lane & 31)] = tv[i]; }
        asm volatile("s_waitcnt lgkmcnt(0)" ::: "memory");
        const int c = lane & 7;
#pragma unroll
        for (int j = 0; j < 4; ++j) { const int n = (lane >> 3) + 8 * j; const LAS float* s = scr + (8 * c) * 33 + n;
            u32x4 o; o.x = pk2(s[0 * 33], s[1 * 33]); o.y = pk2(s[2 * 33], s[3 * 33]); o.z = pk2(s[4 * 33], s[5 * 33]); o.w = pk2(s[6 * 33], s[7 * 33]);
            *(u32x4*)(t.WT + (size_t)(n0 + n) * t.K + k0 + 8 * c) = o; }
        asm volatile("s_waitcnt lgkmcnt(0)" ::: "memory");
    }
}
DI void p0_mods_item(const Params& P, LAS float* sl, int item, int tid) {
    const int l = item / 96, n0 = (item % 96) * 128;
    LAS float* red = sl + 5 * 2048;
    for (int i = tid; i < 5 * 2048; i += 512) { const int v = i >> 11, k = i & 2047; const float cv = v == 0 ? P.c_ctx[k] : P.c[(v - 1) * 2048 + k]; sl[i] = silu(cv); }
    __syncthreads();
    const int cq = tid & 31, ks = tid >> 5;
    const float* W = P.w_ada + (size_t)l * 2048 * NMODS + n0 + cq * 4;
    f32x4 a0 = {0, 0, 0, 0}, a1 = a0, a2 = a0, a3 = a0, a4 = a0;
#pragma unroll 1
    for (int kb = ks * 128; kb < ks * 128 + 128; kb += 32) {
        f32x4 w[32];
#pragma unroll
        for (int i = 0; i < 32; ++i) w[i] = __builtin_nontemporal_load((const f32x4*)(W + (size_t)(kb + i) * NMODS));
#pragma unroll
        for (int i = 0; i < 32; ++i) { const int k = kb + i; a0 += w[i] * sl[k]; a1 += w[i] * sl[2048 + k]; a2 += w[i] * sl[4096 + k]; a3 += w[i] * sl[6144 + k]; a4 += w[i] * sl[8192 + k]; }
    }
    *(LAS f32x4*)(red + (ks * 5 + 0) * 128 + cq * 4) = a0; *(LAS f32x4*)(red + (ks * 5 + 1) * 128 + cq * 4) = a1; *(LAS f32x4*)(red + (ks * 5 + 2) * 128 + cq * 4) = a2;
    *(LAS f32x4*)(red + (ks * 5 + 3) * 128 + cq * 4) = a3; *(LAS f32x4*)(red + (ks * 5 + 4) * 128 + cq * 4) = a4;
    __syncthreads();
    float* mods = (float*)(P.ws + WS_MODS);
    for (int o = tid; o < 640; o += 512) { const int v = o >> 7, cc = o & 127; float s = P.b_ada[l * NMODS + n0 + cc];
        for (int k2 = 0; k2 < 16; ++k2) s += red[(k2 * 5 + v) * 128 + cc];
        mods[(size_t)(l * 5 + v) * NMODS + n0 + cc] = s; }
    __syncthreads();
}
DI void p0_prologue(const Params& P, LAS unsigned char* lds, int tid, int wave, int lane, int part = 0) {
    const int G = gridDim.x, bx = blockIdx.x;
    if (part != 2) for (int it = bx; it < 192; it += G) p0_mods_item(P, (LAS float*)lds, it, tid);
    const int gt = bx * 512 + tid, NT = G * 512;
    {
        float2* rope = (float2*)(P.ws + WS_ROPE);
        for (int i = gt; i < 2048; i += NT) {
            const int pos = i >> 5, f = i & 31; double fr = 1.0; for (int q = 0; q < f; ++q) fr *= 0.74989420933245582730;
            const float ang = (float)pos * (float)fr;
            double x = (double)ang; const double k = __builtin_rint(x * 0.15915494309189533577); x -= k * 6.28318530717958647692;
            const double x2 = x * x; double sn = 0.0, cs = 0.0;
            double term = x; sn = x; for (int t = 1; t < 16; ++t) { term *= -x2 / (double)((2 * t) * (2 * t + 1)); sn += term; }
            term = 1.0; cs = 1.0; for (int t = 1; t < 16; ++t) { term *= -x2 / (double)((2 * t - 1) * (2 * t)); cs += term; }
            rope[i] = make_float2((float)cs, (float)sn);
        }
        bf16* ck = (bf16*)(P.ws + WS_CK); bf16* cvt = (bf16*)(P.ws + WS_CVT);
        for (int i = gt; i < 4 * 2 * 2 * 256 * 128; i += NT) {
            { const int d = i & 127, t = (i >> 7) & 255, kvh = (i >> 15) & 1, bl = i >> 16;
              ck[i] = (bf16)f2bf(P.cache_k[((size_t)bl * 256 + t) * 256 + kvh * 128 + d]); }
            { const int t = i & 255, d = (i >> 8) & 127, kvh = (i >> 15) & 1, bl = i >> 16;
              cvt[i] = (bf16)f2bf(P.cache_v[((size_t)bl * 256 + t) * 256 + kvh * 128 + d]); }
        }
    }
    LAS float* scr = (LAS float*)(lds + wave * 16640);
    const int gw = bx * 8 + wave, NGW = G * 8;
    constexpr int I_IN = 32 * 145, I_OUT = 32 * 32, I_UP = 32 * 176, I_DN = 88 * 32, I_L = I_IN + I_OUT + I_UP + I_DN;
    __syncthreads();
    auto decode = [&](int it) -> TrDesc {
        const int l = it / I_L; int r = it % I_L; TrDesc t; t.up = 0; t.wide = 1;
        if (r < I_IN) { t.W = P.w_in + (size_t)l * 2048 * NIN; t.WT = (bf16*)(P.ws + WS_WIN) + (size_t)l * NINP * 2048; t.K = 2048; t.N = NIN; t.item = r; t.wide = 0; return t; } r -= I_IN;
        if (r < I_OUT) { t.W = P.w_out + (size_t)l * 2048 * 2048; t.WT = (bf16*)(P.ws + WS_WOUT) + (size_t)l * 2048 * 2048; t.K = 2048; t.N = 2048; t.item = r; return t; } r -= I_OUT;
        if (r < I_UP) { t.W = P.w_up + (size_t)l * 2048 * NUP; t.WT = (bf16*)(P.ws + WS_WUP) + (size_t)l * NUP * 2048; t.K = 2048; t.N = NUP; t.item = r; t.up = 1; return t; } r -= I_UP;
        t.W = P.w_down + (size_t)l * DFF * 2048; t.WT = (bf16*)(P.ws + WS_WDN) + (size_t)l * 2048 * DFF; t.K = DFF; t.N = 2048; t.item = r; return t;
    };
    if (part != 1 && gw < 2 * I_L) {
        float tv[64], tn[64]; { const TrDesc t0 = decode(gw); tr_load(tv, t0, lane); }
        for (int it = gw; it < 2 * I_L; it += NGW) {
            const bool has = it + NGW < 2 * I_L;
            if (has) { const TrDesc nxt = decode(it + NGW); tr_load(tn, nxt, lane); }
            { const TrDesc cur = decode(it); tr_store(tv, cur, scr, lane); }
            if (has) {
#pragma unroll
                for (int i = 0; i < 64; ++i) tv[i] = tn[i]; }
        }
    }
}

template <bool SRC16> DI void row_load(f32x4 (&v)[8], const void* src, int lane) {
#pragma unroll
    for (int j = 0; j < 4; ++j) {
        const int o = (j * 64 + lane) * 8;
        if (SRC16) { const u32x4 t = *(const u32x4*)((const bf16*)src + o);
            v[2 * j].x = bf2f(t.x & 0xffffu); v[2 * j].y = bf2f(t.x >> 16); v[2 * j].z = bf2f(t.y & 0xffffu); v[2 * j].w = bf2f(t.y >> 16);
            v[2 * j + 1].x = bf2f(t.z & 0xffffu); v[2 * j + 1].y = bf2f(t.z >> 16); v[2 * j + 1].z = bf2f(t.w & 0xffffu); v[2 * j + 1].w = bf2f(t.w >> 16); }
        else { v[2 * j] = *(const f32x4*)((const float*)src + o); v[2 * j + 1] = *(const f32x4*)((const float*)src + o + 4); }
    }
}
template <bool DO_LN, bool OUT_F32, bool SRC16>
DI void rows8(const void* src0, size_t src_pitch, const float* lw, const float* lb, const float* sh, const float* sc, void* dst0, int lane, float2* stat) {
    f32x4 A[8], B[8];
#pragma unroll
    for (int j = 0; j < 8; ++j) { const int o = ((j >> 1) * 64 + lane) * 8 + (j & 1) * 4;
        f32x4 a = {1.f, 1.f, 1.f, 1.f}, b = {0.f, 0.f, 0.f, 0.f};
        if (lw) { a = *(const f32x4*)(lw + o); b = *(const f32x4*)(lb + o); }
        if (sc) { const f32x4 m = *(const f32x4*)(sc + o) + 1.f; a = a * m; b = b * m + *(const f32x4*)(sh + o); }
        A[j] = a; B[j] = b; }
    f32x4 v[8], vn[8];
    row_load<SRC16>(v, src0, lane);
#pragma unroll 1
    for (int k = 0; k < 8; ++k) {
        if (k < 7) row_load<SRC16>(vn, SRC16 ? (const void*)((const bf16*)src0 + (size_t)(k + 1) * src_pitch) : (const void*)((const float*)src0 + (size_t)(k + 1) * src_pitch), lane);
        if (DO_LN) {
            float s = 0.f;
#pragma unroll
            for (int j = 0; j < 8; ++j) s += (v[j].x + v[j].y) + (v[j].z + v[j].w);
            const float mean = wave_sum(s) * (1.f / DM); float s2 = 0.f;
#pragma unroll
            for (int j = 0; j < 8; ++j) { v[j] = v[j] - mean; s2 += (v[j].x * v[j].x + v[j].y * v[j].y) + (v[j].z * v[j].z + v[j].w * v[j].w); }
            const float rstd = 1.f / sqrtf(wave_sum(s2) * (1.f / DM) + LN_EPS);
            if (stat && lane == 0) stat[k] = make_float2(mean, rstd);
#pragma unroll
            for (int j = 0; j < 8; ++j) v[j] = v[j] * rstd;
        }
#pragma unroll
        for (int j = 0; j < 4; ++j) { const int o = (j * 64 + lane) * 8; const f32x4 h0 = v[2 * j] * A[2 * j] + B[2 * j], h1 = v[2 * j + 1] * A[2 * j + 1] + B[2 * j + 1];
            if (OUT_F32) { *(f32x4*)((float*)dst0 + (size_t)k * DM + o) = h0; *(f32x4*)((float*)dst0 + (size_t)k * DM + o + 4) = h1; }
            else { u32x4 w; w.x = pk2(h0.x, h0.y); w.y = pk2(h0.z, h0.w); w.z = pk2(h1.x, h1.y); w.w = pk2(h1.z, h1.w); *(u32x4*)((bf16*)dst0 + (size_t)k * DM + o) = w; } }
#pragma unroll
        for (int j = 0; j < 8; ++j) v[j] = vn[j];
    }
}

DI void conv_fixup(const Params& P, int l, int tid) {
    const float* eraw = (const float*)(P.ws + WS_ERAW); const float* epart = (const float*)(P.ws + WS_EPART); bf16* ACT = (bf16*)(P.ws + WS_ACT);
    const float* cw = P.conv_w + (size_t)l * 3 * NUP;
    const int gt = blockIdx.x * 512 + tid, NT = gridDim.x * 512;
    for (int it = gt; it < 56 * 1408; it += NT) {
        const int ri = it / 1408, ff = (it % 1408) * 4, b = ri / 14, k = ri % 14, jb = k >> 1, side = k & 1;
        const int pmA = 32 + 8 * b + jb, pmB = pmA + 1;
        const int row = side ? pmB * 256 : pmA * 256 + 255;
        const size_t own = (size_t)(side ? pmB * 2 + 0 : pmA * 2 + 1) * NUP + ff, nb = (size_t)(side ? pmA * 2 + 1 : pmB * 2 + 0) * NUP + ff;
        const float* wn = cw + (side ? 0 : 2 * NUP) + ff;
        const f32x4 a = *(const f32x4*)(epart + own) + *(const f32x4*)wn * *(const f32x4*)(eraw + nb);
        const f32x4 g = *(const f32x4*)(epart + own + DFF) + *(const f32x4*)(wn + DFF) * *(const f32x4*)(eraw + nb + DFF);
        u32x2 w; w.x = pk2(silu(g[0]) * a[0], silu(g[1]) * a[1]); w.y = pk2(silu(g[2]) * a[2], silu(g[3]) * a[3]);
        *(u32x2*)(ACT + (size_t)row * DFF + ff) = w;
    }
}

DI void gla_finalize(LAS unsigned char* lds, const Params& P, int l, int tid, int wave, int lane) {
    const bf16* src[4] = {(const bf16*)(P.ws + WS_OFB), (const bf16*)(P.ws + WS_OFB) + (size_t)MTOK * 1024, (const bf16*)(P.ws + WS_OINT), (const bf16*)(P.ws + WS_OINT) + (size_t)MTOK * 1024};
    const bf16* proj = (const bf16*)(P.ws + WS_PROJ); bf16* cat = (bf16*)(P.ws + WS_CAT);
    const f32x4 nw = *(const f32x4*)(P.gnw + l * 256 + lane * 4);
    LAS float* T = (LAS float*)lds;
    for (int it = blockIdx.x; it < 1024; it += gridDim.x) {
        const int chunk = it >> 2, h = it & 3, row0 = chunk * 64;
        __syncthreads();
#pragma unroll
        for (int i = 0; i < 4; ++i) {
            const int p = tid + 512 * i, v = p >> 3, c8 = p & 7; const size_t go = (size_t)(h * 256 + v) * MTOK + row0 + c8 * 8;
            const bf16x8 a = *(const bf16x8*)(src[0] + go), b = *(const bf16x8*)(src[1] + go), cc = *(const bf16x8*)(src[2] + go), dd = *(const bf16x8*)(src[3] + go);
#pragma unroll
            for (int e = 0; e < 8; ++e) T[(8 * c8 + e) * 257 + v] = (bf2f((unsigned short)a[e]) + bf2f((unsigned short)cc[e])) + (bf2f((unsigned short)b[e]) + bf2f((unsigned short)dd[e]));
        }
        __syncthreads();
#pragma unroll 2
        for (int tk = 0; tk < 8; ++tk) {
            const int tok = wave * 8 + tk, row = row0 + tok;
            f32x4 o; o.x = T[tok * 257 + lane * 4]; o.y = T[tok * 257 + lane * 4 + 1]; o.z = T[tok * 257 + lane * 4 + 2]; o.w = T[tok * 257 + lane * 4 + 3];
            const u32x2 gg = *(const u32x2*)(proj + (size_t)row * PJP + 2304 + h * 256 + lane * 4);
            const float ss = wave_sum((o.x * o.x + o.y * o.y) + (o.z * o.z + o.w * o.w));
            const float rstd = 1.f / sqrtf(ss * (1.f / 256.f) + LN_EPS);
            f32x4 g; g.x = silu(bf2f(gg.x & 0xffffu)); g.y = silu(bf2f(gg.x >> 16)); g.z = silu(bf2f(gg.y & 0xffffu)); g.w = silu(bf2f(gg.y >> 16));
            const f32x4 r = o * rstd * nw * g;
            u32x2 w; w.x = pk2(r.x, r.y); w.y = pk2(r.z, r.w);
            *(u32x2*)(cat + (size_t)row * DM + 1024 + h * 256 + lane * 4) = w;
        }
    }
}

DI void rope_pair(bf16x8& a, bf16x8& b, const float2* cs) {
#pragma unroll
    for (int j = 0; j < 8; ++j) { const float x1 = bf2f((unsigned short)a[j]), x2 = bf2f((unsigned short)b[j]); const float2 t = cs[j];
        a[j] = (short)f2bf(x1 * t.x - x2 * t.y); b[j] = (short)f2bf(x1 * t.y + x2 * t.x); }
}
constexpr int AT_KL = 0, AT_VT = 64 * 136 * 2;
DI void attn_unit(LAS unsigned char* lds, const Params& P, int l, int unit, bool latent, int tid_, int wave, int lane_) {
    int tid = tid_, lane = lane_; asm volatile("" : "+v"(tid), "+v"(lane));
    const int r = lane & 31, hh = lane >> 5;
    int b, head, Q0, RB, T;
    if (latent) { b = unit >> 6; head = (unit >> 3) & 7; Q0 = (unit & 7) * 256; RB = CTXR + b * 2048; T = 2048; }
    else { b = unit >> 3; head = unit & 7; Q0 = 0; RB = b * 256; T = 256; }
    const int kvh = head >> 2;
    const bf16* proj = (const bf16*)(P.ws + WS_PROJ);
    const bf16* vtg = (const bf16*)(P.ws + WS_VT);
    const bf16* ck = (const bf16*)(P.ws + WS_CK) + (size_t)(((b * 2 + l) * 2 + kvh) * 256) * 128;
    const bf16* cvt = (const bf16*)(P.ws + WS_CVT) + (size_t)(((b * 2 + l) * 2 + kvh) * 128) * 256;
    const float2* rope = (const float2*)(P.ws + WS_ROPE);
    const int tq = Q0 + 32 * wave + r;
    const size_t qrow = (size_t)(RB + tq);
    bf16x8 qf[8];
#pragma unroll
    for (int s = 0; s < 8; ++s) qf[s] = *(const bf16x8*)(proj + qrow * PJP + head * 128 + 16 * s + 8 * hh);
    if (latent) {
        const float2* rr = rope + (tq >> 6) * 32 + 8 * hh; const float2* rc = rope + (tq & 63) * 32 + 8 * hh;
        rope_pair(qf[0], qf[2], rr); rope_pair(qf[1], qf[3], rr + 16); rope_pair(qf[4], qf[6], rc); rope_pair(qf[5], qf[7], rc + 16);
    }
    const float SC = 0.08838834764831845f * LOG2E;
    float m = P.sink[l * 8 + head] * LOG2E, lsum = 1.f;
    f32x16 O[4];
#pragma unroll
    for (int d = 0; d < 4; ++d)
#pragma unroll
        for (int i = 0; i < 16; ++i) O[d][i] = 0.f;
    int kstart = 0, nloc = 4, ntiles = 4;
    if (latent) { kstart = Q0 - 128 < 0 ? 0 : Q0 - 128; const int kend = Q0 + 384 > T ? T : Q0 + 384; nloc = (kend - kstart) >> 6; ntiles = nloc + 4; }
    const int skey = tid >> 3, ssub = tid & 7, sd0 = 64 * (ssub >> 2) + 8 * (ssub & 3);
    const bf16* kr = (const bf16*)(P.ws + WS_KR);
    bf16x8 pka, pkb, pv0, pv1;
#define ATT_PREFETCH(TI) do { const int ti_ = (TI); const bool cache_ = ti_ >= nloc; const int k0_ = cache_ ? (ti_ - nloc) * 64 : kstart + ti_ * 64; \
        const bf16* kb_ = cache_ ? ck + (size_t)k0_ * 128 : (latent ? kr + (size_t)(RB - CTXR + k0_) * 256 + kvh * 128 : proj + (size_t)(RB + k0_) * PJP + 1024 + kvh * 128); \
        int t_ = tid; asm volatile("" : "+v"(t_)); const int skey_ = t_ >> 3, ssub_ = t_ & 7, sd0_ = 64 * (ssub_ >> 2) + 8 * (ssub_ & 3); \
        const unsigned kp_ = cache_ ? 128u : (latent ? 256u : (unsigned)PJP); const unsigned ko_ = (unsigned)skey_ * kp_ + (unsigned)sd0_; \
        pka = *(const bf16x8*)(kb_ + ko_); pkb = *(const bf16x8*)(kb_ + ko_ + 32u); \
        const bf16* vb_ = cache_ ? cvt + k0_ : vtg + (size_t)(kvh * 128) * MTOK + RB + k0_; const unsigned vp_ = cache_ ? 256u : (unsigned)MTOK; \
        const unsigned vo_ = (unsigned)(t_ >> 3) * vp_ + (unsigned)(t_ & 7) * 8u; \
        pv0 = *(const bf16x8*)(vb_ + vo_); pv1 = *(const bf16x8*)(vb_ + vo_ + 64u * vp_); } while (0)
    ATT_PREFETCH(0);
    for (int ti = 0; ti < ntiles; ++ti) {
        const bool cache = ti >= nloc; const int k0 = cache ? (ti - nloc) * 64 : kstart + ti * 64;
        const bool local = latent && !cache;
        __syncthreads();
        *(LAS bf16x8*)(lds + AT_KL + (skey * 136 + sd0) * 2) = pka; *(LAS bf16x8*)(lds + AT_KL + (skey * 136 + sd0 + 32) * 2) = pkb;
        { const int d_ = tid >> 3, c8_ = tid & 7; *(LAS bf16x8*)(lds + AT_VT + (d_ * 72 + c8_ * 8) * 2) = pv0; *(LAS bf16x8*)(lds + AT_VT + ((d_ + 64) * 72 + c8_ * 8) * 2) = pv1; }
        __syncthreads();
        if (ti + 1 < ntiles) ATT_PREFETCH(ti + 1);
        if (local) { const int tw = Q0 + 32 * wave; if (k0 + 63 < tw - 128 || k0 > tw + 31 + 128) continue; }
        f32x16 st[2];
        __builtin_amdgcn_s_setprio(1);
#pragma unroll
        for (int kb = 0; kb < 2; ++kb) {
#pragma unroll
            for (int i = 0; i < 16; ++i) st[kb][i] = 0.f;
#pragma unroll
            for (int s = 0; s < 8; ++s) { st[kb] = mfma32(lds16(lds + AT_KL + ((32 * kb + r) * 136 + 16 * s + 8 * hh) * 2), qf[s], st[kb]); if ((s & 3) == 3) __builtin_amdgcn_sched_barrier(0); }
        }
        __builtin_amdgcn_s_setprio(0);
        float mx = -3.0e38f;
#pragma unroll
        for (int kb = 0; kb < 2; ++kb)
#pragma unroll
            for (int i = 0; i < 16; ++i) {
                float z = st[kb][i] * SC;
                if (local) { const int kp = k0 + 32 * kb + crow(i, hh); const int dlt = tq - kp; if (dlt > 128 || dlt < -128) z = -1.0e30f; }
                st[kb][i] = z; mx = fmaxf(mx, z);
            }
        mx = fmaxf(mx, __shfl_xor(mx, 32));
        const float mnew = fmaxf(m, mx), alpha = __builtin_amdgcn_exp2f(m - mnew);
        float rs = 0.f;
#pragma unroll
        for (int kb = 0; kb < 2; ++kb)
#pragma unroll
            for (int i = 0; i < 16; ++i) { const float p = __builtin_amdgcn_exp2f(st[kb][i] - mnew); st[kb][i] = p; rs += p; }
        rs += __shfl_xor(rs, 32);
        lsum = lsum * alpha + rs; m = mnew;
#pragma unroll
        for (int d = 0; d < 4; ++d)
#pragma unroll
            for (int i = 0; i < 16; ++i) O[d][i] *= alpha;
        __builtin_amdgcn_s_setprio(1);
#pragma unroll
        for (int kb = 0; kb < 2; ++kb)
#pragma unroll
            for (int s = 0; s < 2; ++s) {
                const bf16x8 pb = pack8(st[kb], s);
#pragma unroll
                for (int d = 0; d < 4; ++d) {
                    const LAS unsigned char* vp = lds + AT_VT + ((32 * d + r) * 72 + 32 * kb + 16 * s + 4 * hh) * 2;
                    O[d] = mfma32(lds8x2(vp, vp + 16), pb, O[d]);
                }
                __builtin_amdgcn_sched_barrier(0);
            }
        __builtin_amdgcn_s_setprio(0);
    }
    const float inv = 1.f / lsum;
    bf16* cat = (bf16*)(P.ws + WS_CAT) + qrow * DM + head * 128;
#pragma unroll
    for (int d = 0; d < 4; ++d)
#pragma unroll
        for (int g = 0; g < 4; ++g) { u32x2 w; w.x = pk2(O[d][4 * g] * inv, O[d][4 * g + 1] * inv); w.y = pk2(O[d][4 * g + 2] * inv, O[d][4 * g + 3] * inv);
            *(u32x2*)(cat + 32 * d + 8 * g + 4 * hh) = w; }
}

constexpr int GL_QE = 0, GL_KE = 17408, GL_KDT = 34816, GL_VT = 52224, GL_LR = 89088, GL_TOT = 93184, GL_DEC = 95232, GL_WG = 95744;
DI void gla_prep(LAS unsigned char* lds, const Params& P, int l, int it, int tid_, int wave, int lane) {
    const int chunk = it >> 3, h = (it >> 1) & 3, dir = it & 1, row0 = 64 * chunk;
    const bf16* proj = (const bf16*)(P.ws + WS_PROJ);
    const bf16* gvt = (const bf16*)(P.ws + WS_GVT) + (size_t)(h * 256) * MTOK;
    const float* lrb = (const float*)(P.ws + WS_LR);
    bf16* ofb = (bf16*)(P.ws + WS_OFB) + (size_t)dir * MTOK * 1024;
    int d = tid_ & 127, qd = tid_ >> 7, r = lane & 31, hh = lane >> 5, tid = tid_;
    asm volatile("" : "+v"(d), "+v"(qd), "+v"(r), "+v"(hh), "+v"(tid));
    LAS float* LRS = (LAS float*)(lds + GL_LR); LAS float* TOT = (LAS float*)(lds + GL_TOT); LAS float* DEC = (LAS float*)(lds + GL_DEC); LAS float* WGL = (LAS float*)(lds + GL_WG);
    LAS bf16* QE = (LAS bf16*)(lds + GL_QE); LAS bf16* KE = (LAS bf16*)(lds + GL_KE); LAS bf16* KDT = (LAS bf16*)(lds + GL_KDT);
    __syncthreads();
    {
        const float* wg = (dir ? P.wgb : P.wgf) + (size_t)l * 16 * 512 + h * 128;
#pragma unroll
        for (int i = 0; i < 4; ++i) { const int e = tid + 512 * i; WGL[e] = wg[(e >> 7) * 512 + (e & 127)]; }
        if (tid < 256) *(LAS f32x4*)(LRS + tid * 4) = *(const f32x4*)(lrb + (size_t)(row0 + (tid >> 2)) * 32 + dir * 16 + (tid & 3) * 4);
#pragma unroll
        for (int i = 0; i < 4; ++i) { const int piece = tid + 512 * i, v = piece >> 3, c8 = piece & 7;
            *(LAS bf16x8*)(lds + GL_VT + (v * 72 + c8 * 8) * 2) = *(const bf16x8*)(gvt + (size_t)v * MTOK + row0 + c8 * 8); }
    }
    const float bgv = (dir ? P.bgb : P.bgf)[l * 512 + h * 128 + d];
    unsigned qk[16];
    { const unsigned voff = (unsigned)(16 * qd * PJP + d);
#pragma unroll
      for (int i = 0; i < 16; ++i) { const bf16* sb = proj + (size_t)(row0 + i) * PJP + h * 128; qk[i] = (unsigned)sb[voff + 1280u] | ((unsigned)sb[voff + 1792u] << 16); } }
    __syncthreads();
    float bl[16];
#pragma unroll
    for (int i = 0; i < 16; ++i) { float x = bgv;
#pragma unroll
        for (int q = 0; q < 16; ++q) x += LRS[(16 * qd + i) * 16 + q] * WGL[q * 128 + d];
        bl[i] = (fminf(x, 0.f) - flog(1.f + fexp(-fabsf(x)))) * 0.0625f; }
    float run = 0.f;
    if (dir == 0) {
#pragma unroll
        for (int i = 0; i < 16; ++i) { run += bl[i]; bl[i] = run; }
    } else {
#pragma unroll
        for (int i = 15; i >= 0; --i) { run += bl[i]; bl[i] = run; }
    }
    TOT[qd * 128 + d] = run;
    __syncthreads();
    const float t0 = TOT[d], t1 = TOT[128 + d], t2 = TOT[256 + d], t3 = TOT[384 + d];
    const float total = (t0 + t1) + (t2 + t3);
    float off;
    if (dir == 0) off = qd == 0 ? 0.f : qd == 1 ? t0 : qd == 2 ? t0 + t1 : t0 + t1 + t2;
    else off = qd == 3 ? 0.f : qd == 2 ? t3 : qd == 1 ? t3 + t2 : t3 + t2 + t1;
    unsigned kdp[8];
#pragma unroll
    for (int i = 0; i < 16; i += 2) {
        const float b0 = bl[i] + off, b1 = bl[i + 1] + off;
        const float e0 = fexp(b0), e1 = fexp(b1);
        const float q0 = bf2f(qk[i] & 0xffffu), k0v = bf2f(qk[i] >> 16), q1 = bf2f(qk[i + 1] & 0xffffu), k1v = bf2f(qk[i + 1] >> 16);
        QE[(16 * qd + i) * 136 + d] = (bf16)f2bf(q0 * 0.08838834764831845f * e0); QE[(16 * qd + i + 1) * 136 + d] = (bf16)f2bf(q1 * 0.08838834764831845f * e1);
        KE[(16 * qd + i) * 136 + d] = (bf16)f2bf(k0v * fexp(-b0)); KE[(16 * qd + i + 1) * 136 + d] = (bf16)f2bf(k1v * fexp(-b1));
        kdp[i >> 1] = pk2(k0v * fexp(total - b0), k1v * fexp(total - b1));
    }
#pragma unroll
    for (int i = 0; i < 4; ++i) { u32x2 w; w.x = kdp[2 * i]; w.y = kdp[2 * i + 1]; *(LAS u32x2*)(KDT + d * 68 + 16 * qd + 4 * i) = w; }
    if (qd == 0) { ((float*)(P.ws + WS_GDEC))[(size_t)it * 128 + d] = fexp(total); }
    __syncthreads();
    {
        bf16* gqe = (bf16*)(P.ws + WS_GQE) + (size_t)it * 8192; bf16* gkd = (bf16*)(P.ws + WS_GKD) + (size_t)it * 8192;
#pragma unroll
        for (int i = 0; i < 2; ++i) { const int p = tid + 512 * i, row = p >> 4, c16 = p & 15; *(bf16x8*)(gqe + row * 128 + c16 * 8) = lds16(lds + GL_QE + (row * 136 + c16 * 8) * 2); }
#pragma unroll
        for (int i = 0; i < 2; ++i) { const int p = tid + 512 * i, row = p >> 3, c8 = p & 7; const LAS unsigned char* s = lds + GL_KDT + (row * 68 + c8 * 8) * 2; *(bf16x8*)(gkd + row * 64 + c8 * 8) = lds8x2(s, s + 8); }
    }
#pragma unroll 1
    for (int ib = 0; ib < 2; ++ib) {
        f32x16 AT[2];
#pragma unroll
        for (int jb = 0; jb < 2; ++jb) {
#pragma unroll
            for (int i = 0; i < 16; ++i) AT[jb][i] = 0.f;
#pragma unroll
            for (int s = 0; s < 8; ++s)
                AT[jb] = mfma32(lds16(lds + GL_KE + ((32 * jb + r) * 136 + 16 * s + 8 * hh) * 2), lds16(lds + GL_QE + ((32 * ib + r) * 136 + 16 * s + 8 * hh) * 2), AT[jb]);
#pragma unroll
            for (int i = 0; i < 16; ++i) { const int j = 32 * jb + crow(i, hh), ii = 32 * ib + r; const bool keep = dir == 0 ? (j <= ii) : (j >= ii); if (!keep) AT[jb][i] = 0.f; }
        }
        f32x16 o;
#pragma unroll
        for (int i = 0; i < 16; ++i) o[i] = 0.f;
#pragma unroll
        for (int jb = 0; jb < 2; ++jb)
#pragma unroll
            for (int s = 0; s < 2; ++s) {
                const LAS unsigned char* vp = lds + GL_VT + ((32 * wave + r) * 72 + 32 * jb + 16 * s + 4 * hh) * 2;
                o = mfma32(lds8x2(vp, vp + 16), pack8(AT[jb], s), o);
            }
        bf16* op = ofb + (size_t)(h * 256 + 32 * wave + 4 * hh) * MTOK + row0 + 32 * ib + r;
#pragma unroll
        for (int i = 0; i < 16; ++i) op[(size_t)((i & 3) + 8 * (i >> 2)) * MTOK] = (bf16)f2bf(o[i]);
    }
}
DI void rope_k_pass(const Params& P, int tid) {
    const bf16* proj = (const bf16*)(P.ws + WS_PROJ); bf16* kr = (bf16*)(P.ws + WS_KR); const float2* rope = (const float2*)(P.ws + WS_ROPE);
    const int gt = blockIdx.x * 512 + tid, NT = gridDim.x * 512;
    for (int it = gt; it < 8192 * 16; it += NT) {
        const int row = it >> 4, sub = it & 15, kvh = sub >> 3, half = (sub >> 2) & 1, c4 = sub & 3, d0 = kvh * 128 + 64 * half + 8 * c4;
        const bf16* src = proj + (size_t)(CTXR + row) * PJP + 1024 + d0;
        bf16x8 a = *(const bf16x8*)src, b = *(const bf16x8*)(src + 32);
        const int t = row & 2047, pos = half ? (t & 63) : (t >> 6);
        rope_pair(a, b, rope + pos * 32 + 8 * c4);
        *(bf16x8*)(kr + (size_t)row * 256 + d0) = a; *(bf16x8*)(kr + (size_t)row * 256 + d0 + 32) = b;
    }
}
DI void gla_chain(LAS unsigned char* lds, const Params& P, int l, int ci, bool latent, int tid_, int wave, int lane, bf16* dump = nullptr) {
    const int b = ci >> 3, h = (ci >> 1) & 3, dir = ci & 1;
    const int RB = latent ? CTXR + b * 2048 : b * 256, NCH = latent ? 32 : 4;
    const bf16* gvt = (const bf16*)(P.ws + WS_GVT) + (size_t)(h * 256) * MTOK;
    bf16* ofb = (bf16*)(P.ws + WS_OINT) + (size_t)dir * MTOK * 1024;
    const bf16* gqe = (const bf16*)(P.ws + WS_GQE); const bf16* gkd = (const bf16*)(P.ws + WS_GKD); const float* gdec = (const float*)(P.ws + WS_GDEC);
    f32x16 S[4];
    {
        const int r = lane & 31, hh = lane >> 5;
        if (latent) {
            const float* s0 = (dir ? P.st_b : P.st_f) + (size_t)(((b * 2 + l) * 4 + h) * 128) * 256 + 32 * wave + r + 1024 * hh;
#pragma unroll
            for (int k = 0; k < 4; ++k) {
                const float* p = s0 + 8192 * k; asm volatile("" : "+v"(p));
#pragma unroll
                for (int i = 0; i < 16; ++i) S[k][i] = p[((i & 3) + 8 * (i >> 2)) * 256];
            }
        } else {
#pragma unroll
            for (int k = 0; k < 4; ++k)
#pragma unroll
                for (int i = 0; i < 16; ++i) S[k][i] = 0.f;
        }
    }
    LAS float* DEC = (LAS float*)(lds + GL_DEC);
    struct Pre { bf16x8 q0, q1, k0, k1, v[4]; float dec; };
    Pre A, B; A.dec = 0.f; B.dec = 0.f;
#define GLA_PREFETCH(X, STEP) do { const int c_ = dir ? NCH - 1 - (STEP) : (STEP), row0_ = RB + 64 * c_; const size_t it_ = (size_t)(((row0_ >> 6) * 4 + h) * 2 + dir); \
        const bf16* q_ = gqe + it_ * 8192; const bf16* k_ = gkd + it_ * 8192; int t_ = tid_; asm volatile("" : "+v"(t_)); const unsigned to_ = (unsigned)t_ * 8u; \
        X.q0 = *(const bf16x8*)(q_ + to_); X.q1 = *(const bf16x8*)(q_ + (to_ + 4096u)); X.k0 = *(const bf16x8*)(k_ + to_); X.k1 = *(const bf16x8*)(k_ + (to_ + 4096u)); \
        const bf16* v_ = gvt + row0_; const unsigned vo_ = (unsigned)(t_ >> 3) * (unsigned)MTOK + (unsigned)(t_ & 7) * 8u; \
        _Pragma("unroll") for (int i_ = 0; i_ < 4; ++i_) X.v[i_] = *(const bf16x8*)(v_ + (vo_ + (unsigned)(64 * i_) * (unsigned)MTOK)); \
        if (t_ < 128) X.dec = gdec[it_ * 128 + (unsigned)t_]; } while (0)
#define GLA_STEP(X, STEP) do { const int step = (STEP); const int c = dir ? NCH - 1 - step : step, row0 = RB + 64 * c; \
        int r = lane & 31, hh = lane >> 5, tid = tid_; \
        asm volatile("" : "+v"(r), "+v"(hh), "+v"(tid)); \
        __syncthreads(); \
        { const int p = tid, row = p >> 4, c16 = p & 15; *(LAS bf16x8*)(lds + GL_QE + (row * 136 + c16 * 8) * 2) = X.q0; *(LAS bf16x8*)(lds + GL_QE + ((row + 32) * 136 + c16 * 8) * 2) = X.q1; } \
        { const int p = tid, row = p >> 3, c8 = p & 7; LAS unsigned char* s0 = lds + GL_KDT + (row * 68 + c8 * 8) * 2; LAS unsigned char* s1 = lds + GL_KDT + ((row + 64) * 68 + c8 * 8) * 2; \
          const u32x4 w0 = __builtin_bit_cast(u32x4, X.k0), w1 = __builtin_bit_cast(u32x4, X.k1); \
          *(LAS u32x2*)s0 = (u32x2){w0.x, w0.y}; *(LAS u32x2*)(s0 + 8) = (u32x2){w0.z, w0.w}; *(LAS u32x2*)s1 = (u32x2){w1.x, w1.y}; *(LAS u32x2*)(s1 + 8) = (u32x2){w1.z, w1.w}; } \
        _Pragma("unroll") for (int i = 0; i < 4; ++i) { const int piece = tid + 512 * i; *(LAS bf16x8*)(lds + GL_VT + ((piece >> 3) * 72 + (piece & 7) * 8) * 2) = X.v[i]; } \
        if (tid < 128) DEC[tid] = X.dec; \
        __syncthreads(); \
        if (step + 2 < NCH) GLA_PREFETCH(X, step + 2); \
        { f32x16 o0, o1, o2, o3; \
          _Pragma("unroll") for (int i = 0; i < 16; ++i) { o0[i] = 0.f; o1[i] = 0.f; o2[i] = 0.f; o3[i] = 0.f; } \
          _Pragma("unroll") for (int k = 0; k < 4; k += 2) \
            _Pragma("unroll") for (int s = 0; s < 2; ++s) {     \
                const LAS unsigned char* qa = lds + GL_QE + ((r) * 136 + 32 * k + 16 * s + 4 * hh) * 2; const LAS unsigned char* qb = qa + 32 * 136 * 2; \
                const bf16x8 sa = pack8(S[k], s), sb = pack8(S[k + 1], s); \
                o0 = mfma32(sa, lds8x2(qa, qa + 16), o0); o1 = mfma32(sa, lds8x2(qb, qb + 16), o1); \
                o2 = mfma32(sb, lds8x2(qa + 64, qa + 80), o2); o3 = mfma32(sb, lds8x2(qb + 64, qb + 80), o3); } \
          bf16* op = (dump ? dump : ofb) + (size_t)(h * 256 + 32 * wave + 4 * hh) * MTOK + row0 + r; \
          _Pragma("unroll") for (int i = 0; i < 16; ++i) { op[(size_t)((i & 3) + 8 * (i >> 2)) * MTOK] = (bf16)f2bf(o0[i] + o2[i]); op[(size_t)((i & 3) + 8 * (i >> 2)) * MTOK + 32] = (bf16)f2bf(o1[i] + o3[i]); } } \
        _Pragma("unroll") for (int k = 0; k < 4; ++k) { \
            _Pragma("unroll") for (int g = 0; g < 4; ++g) { const f32x4 dv = *(const LAS f32x4*)(DEC + 32 * k + 8 * g + 4 * hh); \
                S[k][4 * g] *= dv.x; S[k][4 * g + 1] *= dv.y; S[k][4 * g + 2] *= dv.z; S[k][4 * g + 3] *= dv.w; } } \
        _Pragma("unroll") for (int s = 0; s < 4; ++s) { \
            const bf16x8 vb = lds16(lds + GL_VT + ((32 * wave + r) * 72 + 16 * s + 8 * hh) * 2); \
            _Pragma("unroll") for (int k = 0; k < 4; ++k) {     \
                const LAS unsigned char* kp = lds + GL_KDT + ((32 * k + r) * 68 + 16 * s + 8 * hh) * 2; \
                S[k] = mfma32(lds8x2(kp, kp + 8), vb, S[k]); } } } while (0)
    GLA_PREFETCH(A, 0); GLA_PREFETCH(B, 1);
#pragma unroll 1
    for (int st2 = 0; st2 < NCH; st2 += 2) { GLA_STEP(A, st2); GLA_STEP(B, st2 + 1); }
#undef GLA_STEP
#undef GLA_PREFETCH
    if (!latent) {
        const int r = lane & 31, hh = lane >> 5;
        float* dst = P.out + (dir ? OUT_SB : OUT_SF) + (size_t)(((b * 2 + l) * 4 + h) * 128) * 256 + 32 * wave + r + 1024 * hh;
#pragma unroll
        for (int k = 0; k < 4; ++k) {
            float* p = dst + 8192 * k; asm volatile("" : "+v"(p));
#pragma unroll
            for (int i = 0; i < 16; ++i) p[((i & 3) + 8 * (i >> 2)) * 256] = S[k][i];
        }
    }
}

#ifndef ONLY
#define SEL(k) true
#else
#define SEL(k) (ONLY == (k))
#endif
DI void run_phase(const Params& P, LAS unsigned char* lds, int ph, int tid, int wave, int lane, int rep = 0) {
    const int G = gridDim.x, bx = blockIdx.x;
    const int gw = bx * 8 + wave, NGW = G * 8;
    bf16* H = (bf16*)(P.ws + WS_H); bf16* XY = (bf16*)(P.ws + WS_XY);
    if (SEL(100) && ph == 0) { p0_prologue(P, lds, tid, wave, lane, rep); return; }
    if (SEL(101) && ph == 1) {
        if (gw < MTOK / 8) {   const int row = gw * 8; const float* md = mods_ptr(P, 0, mv_of_row(row));
            rows8<false, false, false>(row < CTXR ? P.xp + (size_t)row * DM : P.xs + (size_t)(row - CTXR) * DM, DM, nullptr, nullptr, md, md + 2048, H + (size_t)row * DM, lane, nullptr); }
        return;
    }
    const int l = (ph - 2) / NSUB, sub_ = (ph - 2) % NSUB;
    const int sub = sub_ == 0 ? 0 : sub_ == 1 ? 99 : sub_ == 2 ? 1 : sub_ == 3 ? 2 : sub_ == 4 ? 3 : sub_ == 5 ? 4 : sub_ == 6 ? 5 : sub_ == 7 ? 6 : sub_ == 8 ? 9 : 10;
    if (sub_ == 1) {
        rope_k_pass(P, tid);
        for (int it = bx; it < 2048; it += G) gla_prep(lds, P, l, it, tid, wave, lane);
        return;
    }
    if (SEL(0) && sub == 0) {
        pg8::Gemm g{H, (const bf16*)(P.ws + WS_WIN) + (size_t)l * NINP * 2048, MTOK, NINP, 2048}; pg8::StaticOrder S; S.init(MTOK, NINP, G, bx);
        EpiIn E{(bf16*)(P.ws + WS_PROJ), (float*)(P.ws + WS_LR), (bf16*)(P.ws + WS_VT), (bf16*)(P.ws + WS_GVT), P.out + OUT_K + (size_t)l * 65536, P.out + OUT_V + (size_t)l * 65536};
        pg8::gemm_phase<EpiIn, pg8::StaticOrder, false, true>(lds, g, S, E, wave, tid);
    } else if (SEL(1) && sub == 1) {
        unsigned* ctr = (unsigned*)(P.ws + WS_CTL) + 64 * (l + 2 * rep);
        LAS int* slot = (LAS int*)(lds + LDS_BYTES - 64);
        for (;;) {
            __syncthreads();
            if (tid == 0) *slot = (int)atomicAdd(ctr, 1u);
            __syncthreads();
            const int item = __builtin_amdgcn_readfirstlane(*slot);
            if (item >= 800) break;
#ifdef REP_LO
            if (rep && (item < REP_LO || item >= REP_HI)) continue;
#endif
#ifndef NO_GLA
            if (item < 32 || (item >= 288 && item < 544)) gla_chain(lds, P, l, item < 32 ? item : item - 288, item < 32, tid, wave, lane, rep ? (bf16*)P.out : nullptr);
#endif
#ifndef NO_ATT
            if ((item >= 32 && item < 288) || item >= 544) attn_unit(lds, P, l, item < 288 ? item - 32 : item - 544, item < 288, tid, wave, lane);
#endif
        }
    } else if (SEL(2) && sub == 2) {
        gla_finalize(lds, P, l, tid, wave, lane);
    } else if (SEL(3) && (sub == 3 || sub == 9)) {
        const bool dn = sub == 9;
        pg8::Gemm g{dn ? (const bf16*)(P.ws + WS_ACT) : (const bf16*)(P.ws + WS_CAT),
                    dn ? (const bf16*)(P.ws + WS_WDN) + (size_t)l * 2048 * DFF : (const bf16*)(P.ws + WS_WOUT) + (size_t)l * 2048 * 2048, MTOK, 2048, dn ? DFF : 2048};
        pg8::StaticOrder S; S.init(MTOK, 2048, G, bx);
        const bool ext = (!dn && l == 0);
        EpiRes E{P.xp, P.xs, ext ? nullptr : (const bf16*)XY, rep ? (bf16*)P.out : XY, mods_ptr(P, l, 0) + (dn ? 10240 : 4096),
                 (const float2*)(P.ws + WS_STATS), dn ? P.ln1w + l * DM : P.ln2w + (l - 1) * DM, dn ? P.ln1b + l * DM : P.ln2b + (l - 1) * DM};
        pg8::gemm_phase<EpiRes, pg8::StaticOrder, true, true>(lds, g, S, E, wave, tid);
    } else if (SEL(4) && (sub == 4 || sub == 10)) {
        const bool second = sub == 10;
        const float* lw = (second ? P.ln2w : P.ln1w) + l * DM; const float* lb = (second ? P.ln2b : P.ln1b) + l * DM;
        if (rep && second && l == 1) return;
        float2* stats = (float2*)(P.ws + WS_STATS);
        if (gw < MTOK / 8) {   const int row = gw * 8, mv = mv_of_row(row);
            bf16* hd = rep ? (bf16*)(P.out + OUT_K - (size_t)MTOK * DM / 2) + (size_t)row * DM : H + (size_t)row * DM;
            const bf16* src = XY + (size_t)row * DM;
            if (!second) { const float* md = mods_ptr(P, l, mv); rows8<true, false, true>(src, DM, lw, lb, md + 6144, md + 8192, hd, lane, rep ? nullptr : stats + row); }
            else if (l == 0) { const float* md = mods_ptr(P, 1, mv); rows8<true, false, true>(src, DM, lw, lb, md, md + 2048, hd, lane, rep ? nullptr : stats + row); }
            else rows8<true, true, true>(src, DM, lw, lb, nullptr, nullptr, P.out + (size_t)row * DM, lane, nullptr); }
    } else if (SEL(5) && sub == 5) {
        pg8::Gemm g{H, (const bf16*)(P.ws + WS_WUP) + (size_t)l * NUP * 2048, MTOK, NUP, 2048}; pg8::StaticOrder S; S.init(MTOK, NUP, G, bx);
        EpiUpConv E{(bf16*)(P.ws + WS_ACT), (float*)(P.ws + WS_ERAW), (float*)(P.ws + WS_EPART), P.conv_w + (size_t)l * 3 * NUP, P.conv_b + (size_t)l * NUP, (LAS float*)(lds + 131072)};
        pg8::gemm_phase<EpiUpConv, pg8::StaticOrder, true, true>(lds, g, S, E, wave, tid);
    } else if (SEL(6) && sub == 6) {
        conv_fixup(P, l, tid);
    }
}

DI void seam_barrier(unsigned* ctr, unsigned G, int tid) {
    asm volatile("s_waitcnt vmcnt(0) lgkmcnt(0)" ::: "memory");
    __syncthreads();
    if (tid == 0) {
        __builtin_amdgcn_fence(__ATOMIC_RELEASE, "agent");
        asm volatile("s_waitcnt vmcnt(0)" ::: "memory");
        __hip_atomic_fetch_add(ctr, 1u, __ATOMIC_RELAXED, __HIP_MEMORY_SCOPE_AGENT);
        while (__hip_atomic_load(ctr, __ATOMIC_RELAXED, __HIP_MEMORY_SCOPE_AGENT) < G) __builtin_amdgcn_s_sleep(12);
        __builtin_amdgcn_fence(__ATOMIC_ACQUIRE, "agent");
        asm volatile("s_waitcnt vmcnt(0)" ::: "memory");
    }
    __syncthreads();
}
__global__ void __launch_bounds__(512, 2) mega(Params P) {
    extern __shared__ __attribute__((aligned(16))) unsigned char lds_raw[];
    LAS unsigned char* lds = (LAS unsigned char*)lds_raw;
    const int wave = __builtin_amdgcn_readfirstlane((int)threadIdx.x >> 6);
    int ph = P.ph_lo;
    if (ph == 0) {
        const int tid0 = threadIdx.x;
        run_phase(P, lds, 0, tid0, wave, tid0 & 63);
#ifdef DBL_PRO
        __syncthreads(); run_phase(P, lds, 0, tid0, wave, tid0 & 63, DBL_PRO);
#endif
        ++ph;
#if !MK_MULTI
        if (ph < P.ph_hi) cg::this_grid().sync();
#endif
    }
    for (; ph < P.ph_hi; ++ph) {
        int lane; asm volatile("v_mbcnt_lo_u32_b32 %0, -1, 0\n\tv_mbcnt_hi_u32_b32 %0, -1, %0" : "=v"(lane));
        const int tid = wave * 64 + lane;
        if (ph > P.ph_lo && ph > 1) seam_barrier((unsigned*)(P.ws + WS_CTL) + 1024 + 64 * ph, gridDim.x, tid);
        Params Q = P; asm volatile("" : "+s"(Q.ws));
        run_phase(Q, lds, ph, tid, wave, lane);
#ifdef DBL_SUB
        if ((ph >= 2 && ((ph - 2) % NSUB) == DBL_SUB) || (DBL_SUB >= 100 && ph == DBL_SUB - 100)) { seam_barrier((unsigned*)(P.ws + WS_CTL) + 1024 + 64 * (ph + 32), gridDim.x, tid); run_phase(P, lds, ph, tid, wave, lane, 1); }
#endif
    }
}

extern "C" void kernel_launch(void* const* d_in, const int* in_sizes, int n_in, void* d_out, int out_size, void* d_ws, size_t ws_size, hipStream_t stream) {
    static int grid = 0;
    if (grid == 0) {
        if (n_in != 26 || ws_size < WS_END) { fprintf(stderr, "kernel_launch: unexpected n_in %d / ws_size %zu (need %zu)\n", n_in, ws_size, (size_t)WS_END); grid = -1; return; }
        int dev = 0, cus = 0, per_cu = 0;
        if (hipGetDevice(&dev) != hipSuccess || hipDeviceGetAttribute(&cus, hipDeviceAttributeMultiprocessorCount, dev) != hipSuccess) { grid = -1; return; }
        if (hipFuncSetAttribute((const void*)mega, hipFuncAttributeMaxDynamicSharedMemorySize, LDS_BYTES) != hipSuccess) { fprintf(stderr, "kernel_launch: hipFuncSetAttribute failed\n"); grid = -1; return; }
        if (hipOccupancyMaxActiveBlocksPerMultiprocessor(&per_cu, (const void*)mega, 512, LDS_BYTES) != hipSuccess || per_cu < 1) fprintf(stderr, "kernel_launch: occupancy query says %d\n", per_cu);
        (void)hipGetLastError();
        grid = cus;
        if (cus != 256) { fprintf(stderr, "kernel_launch: built for a 256-CU device (got %d)\n", cus); grid = -1; return; }
    }
    if (grid < 0) return;
    (void)hipMemsetAsync((char*)d_ws + WS_CTL, 0, 32768, stream);
    Params p{};
    const float** pp = (const float**)&p;
    for (int i = 0; i < 26; ++i) pp[i] = (const float*)d_in[i];
    p.out = (float*)d_out; p.ws = (unsigned char*)d_ws;
#if MK_MULTI
    for (int ph = 0; ph < NPHASE; ++ph) { p.ph_lo = ph; p.ph_hi = ph + 1; hipLaunchKernelGGL(mega, dim3(grid), dim3(512), LDS_BYTES, stream, p); }
#else
    p.ph_lo = 0; p.ph_hi = NPHASE;
    void* args[] = {&p};
    hipError_t e = hipLaunchCooperativeKernel((const void*)mega, dim3(grid), dim3(512), args, LDS_BYTES, stream);
    if (e != hipSuccess) fprintf(stderr, "cooperative launch failed: %s (grid %d)\n", hipGetErrorString(e), grid);
#endif
}
```
